# Optimizing an MI355X kernel written in HIP

```python
import math
import jax, jax.numpy as jnp
from jax import lax
import numpy as np

D_MODEL = 1024
BATCH = 4
SEQ = 4096
DEPTH = 4
DEC_BATCH = 4
DEC_SEQ = 8192
PAST_LEN = 128

N_MIXERS = 2
N_MLA_LAYERS = (DEPTH + 1) // 2
N_RET_LAYERS = DEPTH // 2
N_NORMS = 4
D_FF = 2816
MLA_HEADS = 8
QK_NOPE_DIM = 128
QK_ROPE_DIM = 64
QK_HEAD_DIM = QK_NOPE_DIM + QK_ROPE_DIM
V_HEAD_DIM = 128
Q_LORA_RANK = 384
KV_LORA_RANK = 256
ROPE_BASE = 10000.0
Q_BLOCK = 128
RET_HEADS = 4
RET_DK = D_MODEL // RET_HEADS
RET_DV = 2 * D_MODEL // RET_HEADS
RET_CHUNK = 128
EPS = 1e-6

kernel_name = "hybrid_mla_retention_macaron_encoder"


def rmsnorm(x, g):
    xf = x.astype(jnp.float32)
    y = xf * lax.rsqrt(jnp.mean(xf * xf, axis=-1, keepdims=True) + EPS)
    return (y * g.astype(jnp.float32)).astype(x.dtype)


def rope_tables(length, dim):
    inv = ROPE_BASE ** (-jnp.arange(0, dim, 2, dtype=jnp.float32) / dim)
    ang = jnp.arange(length, dtype=jnp.float32)[:, None] * inv[None, :]
    return jnp.cos(ang), jnp.sin(ang)


def apply_rope(x, cos, sin):
    half = x.shape[-1] // 2
    xf = x.astype(jnp.float32)
    x1, x2 = xf[..., :half], xf[..., half:]
    c, s = cos[None, :, None, :], sin[None, :, None, :]
    return jnp.concatenate([x1 * c - x2 * s, x2 * c + x1 * s], axis=-1).astype(x.dtype)


def swiglu(x, w_gate, w_up, w_down):
    return (jax.nn.silu(x @ w_gate) * (x @ w_up)) @ w_down


def dense_bidir_attention(q, k, v):
    b, length, h, dh = q.shape
    nq = length // Q_BLOCK
    scale = dh ** -0.5
    kf = k.astype(jnp.float32)
    vf = v.astype(jnp.float32)
    qb = q.reshape(b, nq, Q_BLOCK, h, dh).transpose(1, 0, 2, 3, 4)

    def one_block(qi):
        s = jnp.einsum('bqhd,bkhd->bhqk', qi.astype(jnp.float32), kf) * scale
        p = jax.nn.softmax(s, axis=-1)
        return jnp.einsum('bhqk,bkhd->bqhd', p, vf)

    out = lax.map(one_block, qb)
    return out.transpose(1, 0, 2, 3, 4).reshape(b, length, h, -1).astype(v.dtype)


def mla_mixer(x, w_dq, q_a_norm, w_uq, w_dkv, kv_a_norm, w_ukv, q_norm, k_norm, w_o):
    b, length, _ = x.shape
    cq = rmsnorm(x @ w_dq, q_a_norm)
    q = (cq @ w_uq).reshape(b, length, MLA_HEADS, QK_HEAD_DIM)
    ckv_full = x @ w_dkv
    ckv = rmsnorm(ckv_full[..., :KV_LORA_RANK], kv_a_norm)
    k_pe = ckv_full[..., KV_LORA_RANK:]
    kv = (ckv @ w_ukv).reshape(b, length, MLA_HEADS, QK_NOPE_DIM + V_HEAD_DIM)
    k_nope, v = kv[..., :QK_NOPE_DIM], kv[..., QK_NOPE_DIM:]
    k = jnp.concatenate([k_nope, jnp.broadcast_to(k_pe[:, :, None, :], (b, length, MLA_HEADS, QK_ROPE_DIM))], axis=-1)
    q = rmsnorm(q, q_norm)
    k = rmsnorm(k, k_norm)
    cos, sin = rope_tables(length, QK_ROPE_DIM)
    q = jnp.concatenate([q[..., :QK_NOPE_DIM], apply_rope(q[..., QK_NOPE_DIM:], cos, sin)], axis=-1)
    k = jnp.concatenate([k[..., :QK_NOPE_DIM], apply_rope(k[..., QK_NOPE_DIM:], cos, sin)], axis=-1)
    o = dense_bidir_attention(q, k, v)
    return o.reshape(b, length, MLA_HEADS * V_HEAD_DIM) @ w_o


def retention_scan(q, k, v, log_gamma, strict):
    b, length, h, _ = q.shape
    nc = length // RET_CHUNK
    idx = jnp.arange(RET_CHUNK, dtype=jnp.float32)
    diff = idx[:, None] - idx[None, :]
    mask = (diff > 0) if strict else (diff >= 0)
    decay_in = jnp.where(mask[None], jnp.exp(log_gamma[:, None, None] * jnp.maximum(diff, 0.0)[None]), 0.0)
    xi = jnp.exp(log_gamma[None, :] * (idx[:, None] + 1.0))
    zeta = jnp.exp(log_gamma[None, :] * (RET_CHUNK - 1.0 - idx[:, None]))
    g_chunk = jnp.exp(log_gamma * RET_CHUNK)

    def chunks(t):
        return t.reshape(b, nc, RET_CHUNK, h, -1).transpose(1, 0, 2, 3, 4)

    def step(state, qkv):
        qc, kc, vc = qkv
        s = jnp.einsum('bihd,bjhd->bhij', qc, kc) * decay_in[None]
        inner = jnp.einsum('bhij,bjhe->bihe', s, vc)
        cross = jnp.einsum('bihd,bhde->bihe', qc, state) * xi[None, :, :, None]
        state = state * g_chunk[None, :, None, None] + jnp.einsum('bjhd,bjhe->bhde', kc * zeta[None, :, :, None], vc)
        return state, inner + cross

    state0 = jnp.zeros((b, h, q.shape[-1], v.shape[-1]), jnp.float32)
    _, out = lax.scan(step, state0, (chunks(q), chunks(k), chunks(v)))
    return out.transpose(1, 0, 2, 3, 4).reshape(b, length, h, -1)


def retention_mixer(x, w_in, decay_fwd, decay_bwd, gn_g, w_o):
    b, length, _ = x.shape
    hq = RET_HEADS * RET_DK
    hv = RET_HEADS * RET_DV
    proj = x @ w_in
    q = proj[..., :hq].reshape(b, length, RET_HEADS, RET_DK)
    k = proj[..., hq:2 * hq].reshape(b, length, RET_HEADS, RET_DK)
    v = proj[..., 2 * hq:2 * hq + hv].reshape(b, length, RET_HEADS, RET_DV)
    g = proj[..., 2 * hq + hv:]
    cos, sin = rope_tables(length, RET_DK)
    q = apply_rope(q, cos, sin).astype(jnp.float32)
    k = apply_rope(k, cos, sin).astype(jnp.float32) * (RET_DK ** -0.5)
    vf = v.astype(jnp.float32)
    lg_f = jnp.log1p(-jnp.exp(decay_fwd.astype(jnp.float32)))
    lg_b = jnp.log1p(-jnp.exp(decay_bwd.astype(jnp.float32)))
    o_f = retention_scan(q, k, vf, lg_f, strict=False)
    o_b = jnp.flip(retention_scan(jnp.flip(q, 1), jnp.flip(k, 1), jnp.flip(vf, 1), lg_b, strict=True), 1)
    o = o_f + o_b
    mu = jnp.mean(o, axis=-1, keepdims=True)
    var = jnp.mean(jnp.square(o - mu), axis=-1, keepdims=True)
    o = ((o - mu) * lax.rsqrt(var + EPS)).reshape(b, length, hv) * gn_g.astype(jnp.float32)
    return (jax.nn.silu(g) * o.astype(x.dtype)) @ w_o


def trunk(x, norm_g, ffn_w_gate, ffn_w_up, ffn_w_down,
          mla_w_dq, mla_q_a_norm, mla_w_uq, mla_w_dkv, mla_kv_a_norm, mla_w_ukv,
          mla_q_norm, mla_k_norm, mla_w_o,
          ret_w_in, ret_decay_fwd, ret_decay_bwd, ret_gn_g, ret_w_o):
    for i in range(DEPTH):
        j = i // N_MIXERS
        h = x + 0.5 * swiglu(rmsnorm(x, norm_g[i, 0]), ffn_w_gate[i, 0], ffn_w_up[i, 0], ffn_w_down[i, 0])
        hn = rmsnorm(h, norm_g[i, 1])
        if i % N_MIXERS == 0:
            h = h + mla_mixer(hn, mla_w_dq[j], mla_q_a_norm[j], mla_w_uq[j], mla_w_dkv[j], mla_kv_a_norm[j],
                              mla_w_ukv[j], mla_q_norm[j], mla_k_norm[j], mla_w_o[j])
        else:
            h = h + retention_mixer(hn, ret_w_in[j], ret_decay_fwd[j], ret_decay_bwd[j], ret_gn_g[j], ret_w_o[j])
        h = h + 0.5 * swiglu(rmsnorm(h, norm_g[i, 2]), ffn_w_gate[i, 1], ffn_w_up[i, 1], ffn_w_down[i, 1])
        x = rmsnorm(h, norm_g[i, 3])
    return x


def setup_inputs(seed: int = 0) -> dict:
    key = jax.random.key(seed)
    ks = iter(jax.random.split(key, 32))

    def w(shape, fan_in):
        return jax.random.normal(next(ks), shape, jnp.float32) * (fan_in ** -0.5)

    def gain(shape):
        return 1.0 + 0.02 * jax.random.normal(next(ks), shape, jnp.float32)

    base_decay = -(5.0 + jnp.arange(RET_HEADS, dtype=jnp.float32)) * math.log(2.0)
    return {
        "x_prompt": jax.random.normal(next(ks), (BATCH, SEQ, D_MODEL), jnp.float32),
        "x_sample": jax.random.normal(next(ks), (DEC_BATCH, DEC_SEQ, D_MODEL), jnp.float32),
        "norm_g": gain((DEPTH, N_NORMS, D_MODEL)),
        "ffn_w_gate": w((DEPTH, 2, D_MODEL, D_FF), D_MODEL),
        "ffn_w_up": w((DEPTH, 2, D_MODEL, D_FF), D_MODEL),
        "ffn_w_down": w((DEPTH, 2, D_FF, D_MODEL), D_FF),
        "mla_w_dq": w((N_MLA_LAYERS, D_MODEL, Q_LORA_RANK), D_MODEL),
        "mla_q_a_norm": gain((N_MLA_LAYERS, Q_LORA_RANK)),
        "mla_w_uq": w((N_MLA_LAYERS, Q_LORA_RANK, MLA_HEADS * QK_HEAD_DIM), Q_LORA_RANK),
        "mla_w_dkv": w((N_MLA_LAYERS, D_MODEL, KV_LORA_RANK + QK_ROPE_DIM), D_MODEL),
        "mla_kv_a_norm": gain((N_MLA_LAYERS, KV_LORA_RANK)),
        "mla_w_ukv": w((N_MLA_LAYERS, KV_LORA_RANK, MLA_HEADS * (QK_NOPE_DIM + V_HEAD_DIM)), KV_LORA_RANK),
        "mla_q_norm": gain((N_MLA_LAYERS, QK_HEAD_DIM)),
        "mla_k_norm": gain((N_MLA_LAYERS, QK_HEAD_DIM)),
        "mla_w_o": w((N_MLA_LAYERS, MLA_HEADS * V_HEAD_DIM, D_MODEL), MLA_HEADS * V_HEAD_DIM),
        "ret_w_in": w((N_RET_LAYERS, D_MODEL, RET_HEADS * (2 * RET_DK + 2 * RET_DV)), D_MODEL),
        "ret_decay_fwd": base_decay[None, :] + 0.05 * jax.random.normal(next(ks), (N_RET_LAYERS, RET_HEADS), jnp.float32),
        "ret_decay_bwd": base_decay[None, :] + 0.05 * jax.random.normal(next(ks), (N_RET_LAYERS, RET_HEADS), jnp.float32),
        "ret_gn_g": gain((N_RET_LAYERS, RET_HEADS * RET_DV)),
        "ret_w_o": w((N_RET_LAYERS, RET_HEADS * RET_DV, D_MODEL), RET_HEADS * RET_DV),
    }


def reference(x_prompt, x_sample, norm_g, ffn_w_gate, ffn_w_up, ffn_w_down,
              mla_w_dq, mla_q_a_norm, mla_w_uq, mla_w_dkv, mla_kv_a_norm, mla_w_ukv,
              mla_q_norm, mla_k_norm, mla_w_o,
              ret_w_in, ret_decay_fwd, ret_decay_bwd, ret_gn_g, ret_w_o):
    y_prompt = trunk(x_prompt, norm_g, ffn_w_gate, ffn_w_up, ffn_w_down,
                     mla_w_dq, mla_q_a_norm, mla_w_uq, mla_w_dkv, mla_kv_a_norm, mla_w_ukv,
                     mla_q_norm, mla_k_norm, mla_w_o,
                     ret_w_in, ret_decay_fwd, ret_decay_bwd, ret_gn_g, ret_w_o)
    y_sample = trunk(x_sample, norm_g, ffn_w_gate, ffn_w_up, ffn_w_down,
                     mla_w_dq, mla_q_a_norm, mla_w_uq, mla_w_dkv, mla_kv_a_norm, mla_w_ukv,
                     mla_q_norm, mla_k_norm, mla_w_o,
                     ret_w_in, ret_decay_fwd, ret_decay_bwd, ret_gn_g, ret_w_o)
    return (y_prompt, y_sample)
```

```cpp
#include <hip/hip_runtime.h>
#include <hip/hip_cooperative_groups.h>
#include <cstdio>
#include <cstdint>
#include <cmath>
namespace cg = cooperative_groups;

#define LAS __attribute__((address_space(3)))
typedef unsigned short bf16_t;
typedef short bf16x8 __attribute__((ext_vector_type(8)));
typedef short s16x4 __attribute__((ext_vector_type(4)));
typedef float f32x4 __attribute__((ext_vector_type(4)));
typedef float f32x16 __attribute__((ext_vector_type(16)));
typedef unsigned u32x4 __attribute__((ext_vector_type(4)));
typedef unsigned u32x2 __attribute__((ext_vector_type(2)));

constexpr int T_ALL = 49152, T_GRP = 16384, DM = 1024, FF = 2816;
constexpr float EPS = 1e-6f;
constexpr int LDS_BYTES = 147456;
constexpr size_t MiB = 1u << 20;
constexpr size_t WS_W = 0;
constexpr size_t WS_TAB = 56 * MiB;
constexpr size_t WS_XN = 66 * MiB;
constexpr size_t WS_S = 162 * MiB;
constexpr size_t WS_BAR = WS_S + 352 * MiB;
constexpr size_t WS_END = WS_BAR + 4096;
constexpr size_t WE_GU0 = 0, WE_D0 = WE_GU0 + (size_t)5632 * 1024, WE_GU1 = WE_D0 + (size_t)1024 * 2816, WE_D1 = WE_GU1 + (size_t)5632 * 1024,
                 WE_MIX = WE_D1 + (size_t)1024 * 2816;
constexpr size_t WE_DQKV = WE_MIX, WE_UQ = WE_DQKV + (size_t)768 * 1024, WE_UKV = WE_UQ + (size_t)1536 * 384, WE_MO = WE_UKV + (size_t)2048 * 256;
constexpr size_t WE_RIN = WE_MIX, WE_RO = WE_RIN + (size_t)6144 * 1024;
constexpr size_t S_ACT = 0;
constexpr size_t S_CQKV = 0, S_Q = 72 * MiB, S_KV = 120 * MiB, S_KPE = 184 * MiB;
constexpr size_t S_RQ = 0, S_RK = 32 * MiB, S_RKT = 64 * MiB, S_RV = 96 * MiB, S_RG = 160 * MiB, S_OF = 224 * MiB, S_OB = 288 * MiB;

struct Params {
  const float* xp; const float* xs; const float* norm_g; const float* ffn_g; const float* ffn_u; const float* ffn_d;
  const float* m_dq; const float* m_qa; const float* m_uq; const float* m_dkv; const float* m_kva; const float* m_ukv;
  const float* m_qn; const float* m_kn; const float* m_wo;
  const float* r_in; const float* r_df; const float* r_db; const float* r_gn; const float* r_wo;
  float* out; unsigned char* ws;
  int ph_lo, ph_hi;
};

typedef __bf16 bf16x2_t __attribute__((ext_vector_type(2)));
typedef float f32x2_t __attribute__((ext_vector_type(2)));
__device__ __forceinline__ unsigned cvt_pk_bf16(float lo, float hi) { const f32x2_t v = {lo, hi}; const bf16x2_t b = __builtin_convertvector(v, bf16x2_t); return __builtin_bit_cast(unsigned, b); }
__device__ __forceinline__ float bflo(unsigned w) { return __uint_as_float(w << 16); }
__device__ __forceinline__ float bfhi(unsigned w) { return __uint_as_float(w & 0xffff0000u); }
__device__ __forceinline__ float bf2f(unsigned short u) { return __uint_as_float(((unsigned)u) << 16); }
__device__ __forceinline__ unsigned short f2bf(float f) { return (unsigned short)(cvt_pk_bf16(f, 0.f) & 0xffffu); }
__device__ __forceinline__ float wave_sum(float v) {
#pragma unroll
  for (int o = 32; o > 0; o >>= 1) v += __shfl_xor(v, o);
  return v;
}
__device__ __forceinline__ int tidx() { int t = threadIdx.x; asm volatile("" : "+v"(t)); return t; }
__device__ __forceinline__ float silu_f(float x) { return x * __builtin_amdgcn_rcpf(1.f + __builtin_amdgcn_exp2f(-1.4426950408889634f * x)); }

namespace pg8 {
constexpr int BM = 256, BK = 64, HALF = 128, HTB = HALF * BK * 2, NXCD = 8, WGM = 8;
__host__ __device__ __forceinline__ int lds_byte(int r, int c) { const int st = (r >> 4) * 2 + (c >> 5), rr = r & 15, cc = c & 31, ob = rr * 64 + cc * 2; return st * 1024 + (ob ^ (((ob >> 9) & 1) << 5)); }
__host__ __device__ __forceinline__ void stage_rc(int b, int& R, int& C) { const int st = b / 1024, sb = b % 1024, swz = sb ^ (((sb >> 9) & 1) << 5); R = (st >> 1) * 16 + swz / 64; C = (st & 1) * 32 + (swz % 64) / 2; }
__host__ __device__ __forceinline__ int perm32(int rho) { const int n = rho >> 4, i = rho & 15; return 8 * (i >> 2) + 4 * n + (i & 3); }
struct Unit { int pm, pn; };
struct Gemm { const bf16_t* A; const bf16_t* Bt; int M, N, K, lda; };
struct StaticOrder {
  int nM, nN, nwg, G, c;
  __device__ void init(int M, int N, int G_, int c_) { nM = M / BM; nN = N / BM; nwg = nM * nN; G = G_; c = c_; }
  __device__ bool next(int i, Unit& u) const {
    const long L = (long)i * G + c; if (L >= nwg) return false;
    int wgid = (int)L; { const int q = nwg / NXCD, r = nwg % NXCD, xcd = wgid % NXCD, off = wgid / NXCD; wgid = (xcd < r ? xcd * (q + 1) : r * (q + 1) + (xcd - r) * q) + off; }
    const int nig = WGM * nN, gid = wgid / nig, fm = gid * WGM, gsz = (nM - fm) < WGM ? (nM - fm) : WGM;
    u.pm = fm + ((wgid % nig) % gsz); u.pn = (wgid % nig) / gsz; return true;
  }
};
template <class Epi>
__device__ __forceinline__ void gemm_phase(LAS unsigned char* lds, const Gemm g, const StaticOrder& S, const Epi& E) {
  const int tid = tidx(), wid = __builtin_amdgcn_readfirstlane(tid >> 6), lane = tid & 63, wr = wid >> 2, wc = wid & 3, fr = lane & 15, fq = lane >> 4;
  const int K = g.K, nt = K / BK, lda = g.lda;
  unsigned voffA[2], voffB[2];
#pragma unroll
  for (int i = 0; i < 2; ++i) { int R, C; stage_rc(tid * 16 + i * 8192, R, C); const int Rb = (R & ~31) + perm32(R & 31);
    voffA[i] = (unsigned)(R * lda + C) * 2u; voffB[i] = (unsigned)(Rb * K + C) * 2u; }
  const size_t kstep = (size_t)(BK * 2);
  const size_t hstepA = (size_t)HALF * lda * 2, hstepB = (size_t)HALF * K * 2;
  const size_t tstepA = 2 * hstepA, tstepB = 2 * hstepB;
  const unsigned ldsw = (unsigned)wid * 1024u;
  const int aoff = lds_byte(wr * 64 + fr, fq * 8), boff = lds_byte(wc * 32 + fr, fq * 8);
#define PG8_SA(b, h) (((b) * 2 + (h)) * HTB)
#define PG8_SB(b, h) ((4 + (b) * 2 + (h)) * HTB)
#define PG8_STAGE(bufoff, gbase, voff) do { _Pragma("unroll") for (int _i = 0; _i < 2; ++_i) \
    __builtin_amdgcn_global_load_lds((const unsigned*)((const char*)(gbase) + (voff)[_i]), (LAS unsigned*)(lds + (bufoff) + ldsw + _i * 8192), 16, 0, 0); } while (0)
#define PG8_LDA(dst, b, h) do { _Pragma("unroll") for (int m = 0; m < 4; ++m) _Pragma("unroll") for (int k = 0; k < 2; ++k) dst[m][k] = *(const LAS bf16x8*)(lds + PG8_SA(b, h) + aoff + m * 2048 + k * 1024); } while (0)
#define PG8_LDB(dst, b, h) do { _Pragma("unroll") for (int n = 0; n < 2; ++n) _Pragma("unroll") for (int k = 0; k < 2; ++k) dst[n][k] = *(const LAS bf16x8*)(lds + PG8_SB(b, h) + boff + n * 2048 + k * 1024); } while (0)
#define PG8_MMA(ai, bj, At, Bt) do { __builtin_amdgcn_s_setprio(1); _Pragma("unroll") for (int m = 0; m < 4; ++m) _Pragma("unroll") for (int n = 0; n < 2; ++n) _Pragma("unroll") for (int k = 0; k < 2; ++k) \
    acc[ai][bj][m][n] = __builtin_amdgcn_mfma_f32_16x16x32_bf16(Bt[n][k], At[m][k], acc[ai][bj][m][n], 0, 0, 0); __builtin_amdgcn_s_setprio(0); } while (0)
#define PG8_WAIT_V(n) asm volatile("s_waitcnt vmcnt(" #n ")" ::: "memory")
#define PG8_WAIT_L(n) asm volatile("s_waitcnt lgkmcnt(" #n ")" ::: "memory")
#define PG8_BAR __builtin_amdgcn_s_barrier()
#define PG8_SCHED __builtin_amdgcn_sched_barrier(0)
  Unit cur, nxt; int ui = 0;
  if (!S.next(0, cur)) return;
  f32x4 acc[2][2][4][2];
#pragma unroll
  for (int a = 0; a < 2; ++a)
#pragma unroll
    for (int b = 0; b < 2; ++b)
#pragma unroll
      for (int m = 0; m < 4; ++m)
#pragma unroll
        for (int n = 0; n < 2; ++n) acc[a][b][m][n] = (f32x4){0.f, 0.f, 0.f, 0.f};
  bf16x8 At[4][2], B0[2][2], B1[2][2];
  const char* cA = (const char*)g.A + (size_t)cur.pm * tstepA; const char* cB = (const char*)g.Bt + (size_t)cur.pn * tstepB;
  PG8_STAGE(PG8_SB(0, 0), cB, voffB); PG8_STAGE(PG8_SB(0, 1), cB + hstepB, voffB); PG8_STAGE(PG8_SA(0, 0), cA, voffA); PG8_STAGE(PG8_SA(0, 1), cA + hstepA, voffA);
  if (wr == 1) PG8_BAR;
  PG8_WAIT_V(2); PG8_BAR;
  PG8_STAGE(PG8_SB(1, 0), cB + kstep, voffB); PG8_STAGE(PG8_SA(1, 0), cA + kstep, voffA); PG8_STAGE(PG8_SB(1, 1), cB + hstepB + kstep, voffB);
  PG8_WAIT_V(6); PG8_BAR;
  for (;;) {
    const bool has_next = S.next(ui + 1, nxt);
    const char* nA = has_next ? (const char*)g.A + (size_t)nxt.pm * tstepA : cA; const char* nB = has_next ? (const char*)g.Bt + (size_t)nxt.pn * tstepB : cB;
    for (int t = 0; t < nt; t += 2) {
      const bool last = (t == nt - 2);
      const char* a1 = cA + (size_t)(t + 1) * kstep;
      const char* a2 = last ? nA : cA + (size_t)(t + 2) * kstep; const char* b2 = last ? nB : cB + (size_t)(t + 2) * kstep;
      const char* a3 = a2 + kstep; const char* b3 = b2 + kstep;
      PG8_LDB(B0, 0, 0); PG8_LDB(B1, 0, 1); PG8_SCHED; PG8_LDA(At, 0, 0); PG8_STAGE(PG8_SA(1, 1), a1 + hstepA, voffA);
      PG8_WAIT_V(8); PG8_WAIT_L(0); PG8_BAR; PG8_MMA(0, 0, At, B0); PG8_MMA(0, 1, At, B1); PG8_BAR; PG8_SCHED;
      PG8_LDA(At, 0, 1); PG8_STAGE(PG8_SB(0, 0), b2, voffB); PG8_STAGE(PG8_SB(0, 1), b2 + hstepB, voffB); PG8_STAGE(PG8_SA(0, 0), a2, voffA);
      PG8_WAIT_V(8); PG8_WAIT_L(0); PG8_BAR; PG8_MMA(1, 0, At, B0); PG8_MMA(1, 1, At, B1); PG8_BAR; PG8_SCHED;
      PG8_LDB(B0, 1, 0); PG8_LDB(B1, 1, 1); PG8_SCHED; PG8_LDA(At, 1, 0); PG8_STAGE(PG8_SA(0, 1), a2 + hstepA, voffA);
      PG8_WAIT_V(8); PG8_WAIT_L(0); PG8_BAR; PG8_MMA(0, 0, At, B0); PG8_MMA(0, 1, At, B1); PG8_BAR; PG8_SCHED;
      PG8_LDA(At, 1, 1); PG8_STAGE(PG8_SB(1, 0), b3, voffB); PG8_STAGE(PG8_SB(1, 1), b3 + hstepB, voffB); PG8_STAGE(PG8_SA(1, 0), a3, voffA);
      PG8_WAIT_V(8); PG8_WAIT_L(0); PG8_BAR; PG8_MMA(1, 0, At, B0); PG8_MMA(1, 1, At, B1); PG8_BAR; PG8_SCHED;
    }
    if (wr == 0) PG8_BAR;
    E(acc, cur, wr, wc, fr, fq);
    if (!has_next) break;
#pragma unroll
    for (int a = 0; a < 2; ++a)
#pragma unroll
      for (int b = 0; b < 2; ++b)
#pragma unroll
        for (int m = 0; m < 4; ++m)
#pragma unroll
          for (int n = 0; n < 2; ++n) acc[a][b][m][n] = (f32x4){0.f, 0.f, 0.f, 0.f};
    cur = nxt; cA = nA; cB = nB; ++ui;
    if (wr == 1) PG8_BAR;
  }
  PG8_WAIT_V(0);
  PG8_BAR;
#undef PG8_SA
#undef PG8_SB
#undef PG8_STAGE
#undef PG8_LDA
#undef PG8_LDB
#undef PG8_MMA
#undef PG8_WAIT_V
#undef PG8_WAIT_L
#undef PG8_BAR
#undef PG8_SCHED
}

struct EpiBf16 {
  bf16_t* O; int ldc;
  __device__ __forceinline__ void operator()(const f32x4 (&acc)[2][2][4][2], const Unit& u, int wr, int wc, int fr, int fq) const {
    const int row0 = u.pm * BM + wr * 64 + fr, col0 = u.pn * BM + wc * 32 + 8 * fq;
#pragma unroll
    for (int ai = 0; ai < 2; ++ai)
#pragma unroll
      for (int m = 0; m < 4; ++m) { bf16_t* rowp = O + (size_t)(row0 + ai * HALF + m * 16) * ldc + col0;
#pragma unroll
        for (int bj = 0; bj < 2; ++bj) { const f32x4 v0 = acc[ai][bj][m][0], v1 = acc[ai][bj][m][1];
          u32x4 w; w.x = cvt_pk_bf16(v0[0], v0[1]); w.y = cvt_pk_bf16(v0[2], v0[3]); w.z = cvt_pk_bf16(v1[0], v1[1]); w.w = cvt_pk_bf16(v1[2], v1[3]);
          *(u32x4*)(rowp + bj * HALF) = w; } }
  }
};
struct EpiSwiGLU {
  bf16_t* O;
  __device__ __forceinline__ void operator()(const f32x4 (&acc)[2][2][4][2], const Unit& u, int wr, int wc, int fr, int fq) const {
    const int row0 = u.pm * BM + wr * 64 + fr, col0 = u.pn * 128 + wc * 16 + 4 * fq;
#pragma unroll
    for (int ai = 0; ai < 2; ++ai)
#pragma unroll
      for (int m = 0; m < 4; ++m) { bf16_t* rowp = O + (size_t)(row0 + ai * HALF + m * 16) * FF + col0;
#pragma unroll
        for (int bj = 0; bj < 2; ++bj) { const f32x4 gt = acc[ai][bj][m][0], up = acc[ai][bj][m][1];
          u32x2 w; w.x = cvt_pk_bf16(silu_f(gt[0]) * up[0], silu_f(gt[1]) * up[1]); w.y = cvt_pk_bf16(silu_f(gt[2]) * up[2], silu_f(gt[3]) * up[3]);
          *(u32x2*)(rowp + bj * 64) = w; } }
  }
};
struct EpiResid {
  float* H; float alpha;
  __device__ __forceinline__ void operator()(const f32x4 (&acc)[2][2][4][2], const Unit& u, int wr, int wc, int fr, int fq) const {
    const int row0 = u.pm * BM + wr * 64 + fr, col0 = u.pn * BM + wc * 32 + 8 * fq;
#pragma unroll
    for (int ai = 0; ai < 2; ++ai)
#pragma unroll
      for (int m = 0; m < 4; ++m) { float* rowp = H + (size_t)(row0 + ai * HALF + m * 16) * DM + col0;
#pragma unroll
        for (int bj = 0; bj < 2; ++bj) { f32x4* p = (f32x4*)(rowp + bj * HALF);
          f32x4 a = p[0], b = p[1]; a += acc[ai][bj][m][0] * alpha; b += acc[ai][bj][m][1] * alpha; p[0] = a; p[1] = b; } }
  }
};
struct EpiRet {
  bf16_t* RQ; bf16_t* RK; bf16_t* RKT; bf16_t* RV; bf16_t* RG; const float* ctab; const float* stab; int seqmask;
  __device__ __forceinline__ void operator()(const f32x4 (&acc)[2][2][4][2], const Unit& u, int wr, int wc, int fr, int fq) const {
    const int row0 = u.pm * BM + wr * 64 + fr; const int pn = u.pn; const int cin = wc * 32 + 8 * fq;
    if (pn < 8) {
      const bool isk = pn >= 4; const int head = pn & 3; const float sc = isk ? 0.0625f : 1.f;
      bf16_t* dst = isk ? RK : RQ;
#pragma unroll
      for (int ai = 0; ai < 2; ++ai)
#pragma unroll
        for (int m = 0; m < 4; ++m) { const int lr = row0 + ai * HALF + m * 16; const int pos = lr & seqmask;
          const float* cp = ctab + (size_t)pos * 128 + cin; const float* sp = stab + (size_t)pos * 128 + cin;
          float o1[8], o2[8];
#pragma unroll
          for (int n = 0; n < 2; ++n) { const f32x4 c4 = *(const f32x4*)(cp + 4 * n), s4 = *(const f32x4*)(sp + 4 * n); const f32x4 x1 = acc[ai][0][m][n], x2 = acc[ai][1][m][n];
#pragma unroll
            for (int j = 0; j < 4; ++j) { o1[4 * n + j] = (x1[j] * c4[j] - x2[j] * s4[j]) * sc; o2[4 * n + j] = (x2[j] * c4[j] + x1[j] * s4[j]) * sc; } }
          u32x4 w1, w2; w1.x = cvt_pk_bf16(o1[0], o1[1]); w1.y = cvt_pk_bf16(o1[2], o1[3]); w1.z = cvt_pk_bf16(o1[4], o1[5]); w1.w = cvt_pk_bf16(o1[6], o1[7]);
          w2.x = cvt_pk_bf16(o2[0], o2[1]); w2.y = cvt_pk_bf16(o2[2], o2[3]); w2.z = cvt_pk_bf16(o2[4], o2[5]); w2.w = cvt_pk_bf16(o2[6], o2[7]);
          bf16_t* rp = dst + (size_t)lr * 1024 + head * 256 + cin;
          *(u32x4*)rp = w1; *(u32x4*)(rp + 128) = w2;
          if (isk) { bf16_t* tp = RKT + ((size_t)((lr >> 6) * 4 + head) * 256 + cin) * 64 + (lr & 63);
#pragma unroll
            for (int e = 0; e < 8; ++e) { tp[(size_t)e * 64] = f2bf(o1[e]); tp[(size_t)(e + 128) * 64] = f2bf(o2[e]); } }
        }
    } else {
      const bool isg = pn >= 16; bf16_t* dst = isg ? RG : RV; const int cbase = (isg ? pn - 16 : pn - 8) * 256 + cin;
#pragma unroll
      for (int ai = 0; ai < 2; ++ai)
#pragma unroll
        for (int m = 0; m < 4; ++m) { bf16_t* rowp = dst + (size_t)(row0 + ai * HALF + m * 16) * 2048 + cbase;
#pragma unroll
          for (int bj = 0; bj < 2; ++bj) { f32x4 v0 = acc[ai][bj][m][0], v1 = acc[ai][bj][m][1];
            if (isg) {
#pragma unroll
              for (int j = 0; j < 4; ++j) { v0[j] = silu_f(v0[j]); v1[j] = silu_f(v1[j]); } }
            u32x4 w; w.x = cvt_pk_bf16(v0[0], v0[1]); w.y = cvt_pk_bf16(v0[2], v0[3]); w.z = cvt_pk_bf16(v1[0], v1[1]); w.w = cvt_pk_bf16(v1[2], v1[3]);
            *(u32x4*)(rowp + bj * HALF) = w; } }
    }
  }
};
}

namespace att {
constexpr int KVBLK = 64;
constexpr float SCALE = 0.07216878364870323f;
constexpr float THR = 8.f;
constexpr int SHM_K = KVBLK * 192 * 2, SHM_V = KVBLK * 128 * 2;
#define KSWZ(row, colB) ((row) * 384 + ((colB) ^ (((row) & 7) << 4)))
#define SBAR() __builtin_amdgcn_sched_barrier(0)
__device__ __forceinline__ int crow(int r, int hi) { return (r & 3) + 8 * (r >> 2) + 4 * hi; }
__device__ __forceinline__ void partialSM(f32x16& p0, f32x16& p1, float& m_reg, float& mn, float& alpha) {
  constexpr float C = SCALE * 1.4426950408889634f;
  float pmax = p0[0];
#pragma unroll
  for (int r = 1; r < 16; ++r) pmax = fmaxf(pmax, p0[r]);
#pragma unroll
  for (int r = 0; r < 16; ++r) pmax = fmaxf(pmax, p1[r]);
  { auto rr = __builtin_amdgcn_permlane32_swap(__float_as_uint(pmax), __float_as_uint(pmax), false, false);
    pmax = fmaxf(__uint_as_float(rr[0]), __uint_as_float(rr[1])); }
  if (__builtin_expect(__all(pmax - m_reg <= THR / SCALE), 1)) { mn = m_reg; alpha = 1.f; }
  else { mn = fmaxf(m_reg, pmax); alpha = __builtin_amdgcn_exp2f((m_reg - mn) * C); m_reg = mn; }
  const float mnC = -mn * C;
#pragma unroll
  for (int r = 0; r < 16; ++r) p0[r] = __builtin_amdgcn_exp2f(fmaf(p0[r], C, mnC));
#pragma unroll
  for (int r = 0; r < 16; ++r) p1[r] = __builtin_amdgcn_exp2f(fmaf(p1[r], C, mnC));
}
__device__ __forceinline__ void finishSM(f32x16& p0, f32x16& p1, float alpha, float& l_reg, bf16x8& pa0, bf16x8& pa1, bf16x8& pa2, bf16x8& pa3) {
  float ps = 0;
#pragma unroll
  for (int r = 0; r < 16; ++r) ps += p0[r];
#pragma unroll
  for (int r = 0; r < 16; ++r) ps += p1[r];
  { auto rr = __builtin_amdgcn_permlane32_swap(__float_as_uint(ps), __float_as_uint(ps), false, false);
    ps = __uint_as_float(rr[0]) + __uint_as_float(rr[1]); }
  l_reg = l_reg * alpha + ps;
#define PK4(P, BASE, OUT) do { unsigned a0 = cvt_pk_bf16(P[BASE + 0], P[BASE + 1]), a1 = cvt_pk_bf16(P[BASE + 2], P[BASE + 3]);   \
    unsigned b0 = cvt_pk_bf16(P[BASE + 4], P[BASE + 5]), b1 = cvt_pk_bf16(P[BASE + 6], P[BASE + 7]);                              \
    auto r0 = __builtin_amdgcn_permlane32_swap(a0, b0, false, false); auto r1 = __builtin_amdgcn_permlane32_swap(a1, b1, false, false); \
    u32x4 w = {r0[0], r1[0], r0[1], r1[1]}; OUT = *reinterpret_cast<bf16x8*>(&w); } while (0)
  PK4(p0, 0, pa0); PK4(p0, 8, pa1); PK4(p1, 0, pa2); PK4(p1, 8, pa3);
#undef PK4
}
__device__ __forceinline__ void qkt(f32x16& p0, f32x16& p1, const char* Ks, const bf16x8* qr, int r32, int hi) {
  p0 = f32x16{}; p1 = f32x16{};
#pragma unroll
  for (int d0 = 0; d0 < 12; ++d0) { const int cb = (d0 * 16 + hi * 8) * 2;
    const bf16x8 b0 = *reinterpret_cast<const bf16x8*>(Ks + KSWZ(r32, cb));
    const bf16x8 b1 = *reinterpret_cast<const bf16x8*>(Ks + KSWZ(32 + r32, cb));
    p0 = __builtin_amdgcn_mfma_f32_32x32x16_bf16(b0, qr[d0], p0, 0, 0, 0);
    p1 = __builtin_amdgcn_mfma_f32_32x32x16_bf16(b1, qr[d0], p1, 0, 0, 0); }
}
__device__ __forceinline__ int v_st(int k, int c) { const int kk = (k & ~0xC) | ((k & 4) << 1) | ((k & 8) >> 1); return ((kk >> 3) * 4 + (c >> 5)) * 512 + ((kk & 7) * 32 + (c & 31)) * 2; }
__device__ __forceinline__ int v_rd_base(int lane) { return ((lane & 3) << 3) | (((lane >> 2) & 3) << 6) | (((lane >> 4) & 1) << 5) | (((lane >> 5) & 1) << 8); }
constexpr int v_rd_off(int d0, int ks, int half) { return d0 * 512 + ks * 4096 + half * 2048; }
template <int OFF> __device__ __forceinline__ s16x4 tr_read(int vb) {
  s16x4 r; asm volatile("ds_read_b64_tr_b16 %0, %1 offset:%2" : "=&v"(r) : "v"(vb), "i"(OFF) : "memory"); return r;
}
template <int D0> __device__ __forceinline__ void pv_one(f32x16& od, int vb, bf16x8 pa0, bf16x8 pa1, bf16x8 pa2, bf16x8 pa3) {
  const s16x4 l0 = tr_read<v_rd_off(D0, 0, 0)>(vb), h0 = tr_read<v_rd_off(D0, 0, 1)>(vb), l1 = tr_read<v_rd_off(D0, 1, 0)>(vb), h1 = tr_read<v_rd_off(D0, 1, 1)>(vb);
  const s16x4 l2 = tr_read<v_rd_off(D0, 2, 0)>(vb), h2 = tr_read<v_rd_off(D0, 2, 1)>(vb), l3 = tr_read<v_rd_off(D0, 3, 0)>(vb), h3 = tr_read<v_rd_off(D0, 3, 1)>(vb);
  asm volatile("s_waitcnt lgkmcnt(0)" ::: "memory"); SBAR();
#define PK(L, H) (bf16x8){L[0], L[1], L[2], L[3], H[0], H[1], H[2], H[3]}
  od = __builtin_amdgcn_mfma_f32_32x32x16_bf16(pa0, PK(l0, h0), od, 0, 0, 0);
  od = __builtin_amdgcn_mfma_f32_32x32x16_bf16(pa1, PK(l1, h1), od, 0, 0, 0);
  od = __builtin_amdgcn_mfma_f32_32x32x16_bf16(pa2, PK(l2, h2), od, 0, 0, 0);
  od = __builtin_amdgcn_mfma_f32_32x32x16_bf16(pa3, PK(l3, h3), od, 0, 0, 0);
#undef PK
}
__device__ __forceinline__ void pv_d0(f32x16* o, int vb, bf16x8 pa0, bf16x8 pa1, bf16x8 pa2, bf16x8 pa3) {
  pv_one<0>(o[0], vb, pa0, pa1, pa2, pa3); pv_one<1>(o[1], vb, pa0, pa1, pa2, pa3); pv_one<2>(o[2], vb, pa0, pa1, pa2, pa3); pv_one<3>(o[3], vb, pa0, pa1, pa2, pa3);
}
__device__ __forceinline__ void attn_unit(const bf16_t* __restrict__ Qb, const bf16_t* __restrict__ KVh, const bf16_t* __restrict__ KPEh, bf16_t* __restrict__ Ob, int seq, char* lds, int ldsoff) {
  const int tid = tidx(), wid = tid >> 6, lane = tid & 63, r32 = lane & 31, hi = lane >> 5;
  char* V_lds = lds; char* K_lds = lds + 2 * SHM_V;
  float* ws = (float*)(lds + 2 * SHM_V + 2 * SHM_K) + wid * 64; float* li_l = ws; float* al_l = ws + 32;
  float m_reg = -1e30f, l_reg = 0; f32x16 o[4] = {}; bf16x8 qr[12];
  const bf16_t* Qw = Qb + (long)(wid * 32 + r32) * 1536 + hi * 8;
#pragma unroll
  for (int d0 = 0; d0 < 12; ++d0) qr[d0] = *reinterpret_cast<const bf16x8*>(Qw + d0 * 16);
  const int sr = tid >> 4, sc = (tid & 15) * 8, vst0 = v_st(sr, sc), vst1 = v_st(32 + sr, sc);
  const int pr = tid >> 3, pc = (tid & 7) * 8;
  const int vb0 = ldsoff + v_rd_base(lane);
  bf16x8 vs0, vs1, ks0, ks1, kp;
#define SLOAD(k0) do { vs0 = *reinterpret_cast<const bf16x8*>(&KVh[(long)((k0) + sr) * 2048 + 128 + sc]); vs1 = *reinterpret_cast<const bf16x8*>(&KVh[(long)((k0) + 32 + sr) * 2048 + 128 + sc]); \
    ks0 = *reinterpret_cast<const bf16x8*>(&KVh[(long)((k0) + sr) * 2048 + sc]); ks1 = *reinterpret_cast<const bf16x8*>(&KVh[(long)((k0) + 32 + sr) * 2048 + sc]); \
    kp = *reinterpret_cast<const bf16x8*>(&KPEh[(long)((k0) + pr) * 512 + pc]); } while (0)
#define SWRITE(b) do { *(bf16x8*)(V_lds + (b) * SHM_V + vst0) = vs0; *(bf16x8*)(V_lds + (b) * SHM_V + vst1) = vs1; \
    *(bf16x8*)(K_lds + (b) * SHM_K + KSWZ(sr, sc * 2)) = ks0; *(bf16x8*)(K_lds + (b) * SHM_K + KSWZ(32 + sr, sc * 2)) = ks1; \
    *(bf16x8*)(K_lds + (b) * SHM_K + KSWZ(pr, (128 + pc) * 2)) = kp; } while (0)
  f32x16 p0, p1; float mn, al; bf16x8 pa0, pa1, pa2, pa3; const int NT = seq / KVBLK;
  SLOAD(0); asm volatile("s_waitcnt vmcnt(0)" ::: "memory"); SWRITE(0); __syncthreads();
  for (int j = 0; j < NT; ++j) {
    const int b = j & 1;
    if (j + 1 < NT) SLOAD((j + 1) * KVBLK);
    SBAR();
    qkt(p0, p1, K_lds + b * SHM_K, qr, r32, hi);
    partialSM(p0, p1, m_reg, mn, al);
    if (__any(al < 1.f)) { if (hi == 0) al_l[r32] = al; asm volatile("s_waitcnt lgkmcnt(0)" ::: "memory");
#pragma unroll
      for (int d = 0; d < 4; ++d)
#pragma unroll
        for (int r = 0; r < 16; ++r) o[d][r] *= al_l[crow(r, hi)]; }
    finishSM(p0, p1, al, l_reg, pa0, pa1, pa2, pa3); SBAR();
    pv_d0(o, vb0 + b * SHM_V, pa0, pa1, pa2, pa3);
    if (j + 1 < NT) { asm volatile("s_waitcnt vmcnt(0)" ::: "memory"); SWRITE(b ^ 1); }
    __syncthreads();
  }
  if (hi == 0) li_l[r32] = l_reg; asm volatile("s_waitcnt lgkmcnt(0)" ::: "memory");
  float rli[16];
#pragma unroll
  for (int r = 0; r < 16; ++r) rli[r] = __builtin_amdgcn_rcpf(li_l[crow(r, hi)]);
  bf16_t* Ow = Ob + (long)(wid * 32) * 1024;
#pragma unroll
  for (int r = 0; r < 16; ++r) { const int orow = crow(r, hi);
#pragma unroll
    for (int d0 = 0; d0 < 4; ++d0) Ow[(long)orow * 1024 + d0 * 32 + r32] = f2bf(o[d0][r] * rli[r]); }
  __syncthreads();
#undef SLOAD
#undef SWRITE
}
}

namespace ret {
constexpr int QS = 0, KS = 33792, KTS = 67584, STS = 104448, PS = 121344, VTS = 130560, VZS = 135168;
constexpr int RS = 528, TS = 144;
__device__ __forceinline__ f32x4 mma16(bf16x8 a, bf16x8 b, f32x4 c) { return __builtin_amdgcn_mfma_f32_16x16x32_bf16(a, b, c, 0, 0, 0); }
__device__ __forceinline__ void scan_item(LAS unsigned char* L, const bf16_t* __restrict__ RQ, const bf16_t* __restrict__ RK, const bf16_t* __restrict__ RKT, const bf16_t* __restrict__ RV,
                                          bf16_t* __restrict__ Oo, int seqlen, int s, int hd, int dir, int sl, float lg2) {
  const int tid = tidx(), wid = tid >> 6, lane = tid & 63, l15 = lane & 15, g4 = lane >> 4;
  const int nchunk = seqlen >> 6;
  const int it = wid >> 1, vt = wid & 1, jt0 = 2 * (wid & 1);
  f32x4 st[2][2];
#pragma unroll
  for (int a = 0; a < 2; ++a)
#pragma unroll
    for (int b = 0; b < 2; ++b) st[a][b] = (f32x4){0.f, 0.f, 0.f, 0.f};
  const float gch = __builtin_amdgcn_exp2f(64.f * lg2);
  u32x4 pq[4], pk[4], pt[4], pv;
  const int vrow = tid >> 2, vc4 = tid & 3;
#define RLOAD(c) do { const long tok0 = (long)s * seqlen + (long)(c) * 64; \
    _Pragma("unroll") for (int i = 0; i < 4; ++i) { const int q = tid + 512 * i; const int row = q >> 5, c16 = q & 31; \
      pq[i] = *(const u32x4*)(RQ + (tok0 + row) * 1024 + hd * 256 + c16 * 8); pk[i] = *(const u32x4*)(RK + (tok0 + row) * 1024 + hd * 256 + c16 * 8); \
      pt[i] = *(const u32x4*)(RKT + (((tok0 >> 6) * 4 + hd) * 256) * 64 + (long)q * 8); } \
    if (tid < 256) pv = *(const u32x4*)(RV + (tok0 + vrow) * 2048 + hd * 512 + sl * 32 + vc4 * 8); } while (0)
  RLOAD(dir ? nchunk - 1 : 0);
#ifndef DBG_STEPS
#define DBG_STEPS nchunk
#endif
  for (int cc = 0; cc < DBG_STEPS; ++cc) {
    const int c = dir ? nchunk - 1 - cc : cc;
#pragma unroll
    for (int i = 0; i < 4; ++i) { const int q = tid + 512 * i; const int row = q >> 5, c16 = q & 31;
      *(LAS u32x4*)(L + QS + row * RS + c16 * 16) = pq[i]; *(LAS u32x4*)(L + KS + row * RS + c16 * 16) = pk[i];
      const int dr = q >> 3, c8 = q & 7; *(LAS u32x4*)(L + KTS + dr * TS + c8 * 16) = pt[i]; }
    if (tid < 256) { const float zeta = __builtin_amdgcn_exp2f((dir ? (float)vrow : (float)(63 - vrow)) * lg2);
      const unsigned wv[4] = {pv.x, pv.y, pv.z, pv.w};
#pragma unroll
      for (int e = 0; e < 8; ++e) { const unsigned w = wv[e >> 1]; const unsigned short raw = (e & 1) ? (unsigned short)(w >> 16) : (unsigned short)(w & 0xffffu);
        const int dv = vc4 * 8 + e;
        *(LAS unsigned short*)(L + VTS + dv * TS + vrow * 2) = raw;
        *(LAS unsigned short*)(L + VZS + dv * TS + vrow * 2) = f2bf(bf2f(raw) * zeta); } }
#pragma unroll
    for (int a = 0; a < 2; ++a)
#pragma unroll
      for (int b = 0; b < 2; ++b) { const int d = 16 * (2 * wid + a) + 4 * g4, dv = 16 * b + l15;
        u32x2 w; w.x = cvt_pk_bf16(st[a][b][0], st[a][b][1]); w.y = cvt_pk_bf16(st[a][b][2], st[a][b][3]);
        *(LAS u32x2*)(L + STS + dv * RS + d * 2) = w; }
    __syncthreads();
    if (cc + 1 < nchunk) RLOAD(dir ? nchunk - 2 - cc : cc + 1);
    f32x4 sS0 = {0.f, 0.f, 0.f, 0.f}, sS1 = {0.f, 0.f, 0.f, 0.f}, cX = {0.f, 0.f, 0.f, 0.f};
#pragma unroll
    for (int ks = 0; ks < 8; ++ks) { const int ko = (ks * 32 + 8 * g4) * 2;
      const bf16x8 a = *(const LAS bf16x8*)(L + QS + (16 * it + l15) * RS + ko);
      const bf16x8 b0 = *(const LAS bf16x8*)(L + KS + (16 * jt0 + l15) * RS + ko);
      const bf16x8 b1 = *(const LAS bf16x8*)(L + KS + (16 * (jt0 + 1) + l15) * RS + ko);
      const bf16x8 b2 = *(const LAS bf16x8*)(L + STS + (16 * vt + l15) * RS + ko);
      sS0 = mma16(a, b0, sS0); sS1 = mma16(a, b1, sS1); cX = mma16(a, b2, cX); }
    {
#pragma unroll
      for (int r = 0; r < 4; ++r) { const int i = 16 * it + 4 * g4 + r;
        const int j0 = 16 * jt0 + l15, j1 = j0 + 16;
        const float w0 = dir ? (j0 > i ? __builtin_amdgcn_exp2f((float)(j0 - i) * lg2) : 0.f) : (i >= j0 ? __builtin_amdgcn_exp2f((float)(i - j0) * lg2) : 0.f);
        const float w1 = dir ? (j1 > i ? __builtin_amdgcn_exp2f((float)(j1 - i) * lg2) : 0.f) : (i >= j1 ? __builtin_amdgcn_exp2f((float)(i - j1) * lg2) : 0.f);
        *(LAS unsigned short*)(L + PS + i * TS + j0 * 2) = f2bf(sS0[r] * w0);
        *(LAS unsigned short*)(L + PS + i * TS + j1 * 2) = f2bf(sS1[r] * w1);
        const float xi = __builtin_amdgcn_exp2f((dir ? (float)(64 - i) : (float)(i + 1)) * lg2);
        cX[r] *= xi; }
    }
#pragma unroll
    for (int a = 0; a < 2; ++a)
#pragma unroll
      for (int b = 0; b < 2; ++b) st[a][b] *= gch;
#pragma unroll
    for (int ks = 0; ks < 2; ++ks) { const int ko = (ks * 32 + 8 * g4) * 2;
      const bf16x8 a0 = *(const LAS bf16x8*)(L + KTS + (16 * (2 * wid) + l15) * TS + ko);
      const bf16x8 a1 = *(const LAS bf16x8*)(L + KTS + (16 * (2 * wid + 1) + l15) * TS + ko);
      const bf16x8 b0 = *(const LAS bf16x8*)(L + VZS + (l15) * TS + ko);
      const bf16x8 b1 = *(const LAS bf16x8*)(L + VZS + (16 + l15) * TS + ko);
      st[0][0] = mma16(a0, b0, st[0][0]); st[0][1] = mma16(a0, b1, st[0][1]); st[1][0] = mma16(a1, b0, st[1][0]); st[1][1] = mma16(a1, b1, st[1][1]); }
    __syncthreads();
#pragma unroll
    for (int ks = 0; ks < 2; ++ks) { const int ko = (ks * 32 + 8 * g4) * 2;
      const bf16x8 a = *(const LAS bf16x8*)(L + PS + (16 * it + l15) * TS + ko);
      const bf16x8 b = *(const LAS bf16x8*)(L + VTS + (16 * vt + l15) * TS + ko);
      cX = mma16(a, b, cX); }
    { const long tok0 = (long)s * seqlen + (long)c * 64;
#pragma unroll
      for (int r = 0; r < 4; ++r) { const int i = 16 * it + 4 * g4 + r;
#ifdef DBG_LDSONLY
        const int dvv = 16 * vt + l15;
        float acc_ = bf2f(*(const LAS unsigned short*)(L + QS + i * RS + dvv * 2)) + bf2f(*(const LAS unsigned short*)(L + KS + i * RS + (dvv + 64) * 2))
                   + bf2f(*(const LAS unsigned short*)(L + KTS + (dvv + 32 * (i & 7)) * TS + i * 2)) + bf2f(*(const LAS unsigned short*)(L + VTS + dvv * TS + i * 2))
                   + bf2f(*(const LAS unsigned short*)(L + VZS + dvv * TS + i * 2)) + bf2f(*(const LAS unsigned short*)(L + STS + dvv * RS + (i * 4) * 2));
        cX[r] = acc_;
#endif
        Oo[((long)(hd * 16 + sl) * T_GRP + tok0 + i) * 32 + 16 * vt + l15] = f2bf(cX[r]); } }
    __syncthreads();
  }
#undef RLOAD
}
}

__device__ __forceinline__ void prep_T(float* tile, const float* __restrict__ W, int K, int N, bf16_t* __restrict__ Bt, int mode, int row_off, int& base) {
  const int G = gridDim.x, tid = tidx();
  const int tn = N >> 6, ntile = (K >> 6) * tn;
  int t0 = ((int)blockIdx.x - base % G + G) % G;
  for (int t = t0; t < ntile; t += G) {
    const int k0 = (t / tn) << 6, n0 = (t % tn) << 6;
#pragma unroll
    for (int i = 0; i < 2; ++i) { const int kr = (tid >> 4) + 32 * i, nc = (tid & 15) * 4;
      const f32x4 v = *(const f32x4*)(W + (size_t)(k0 + kr) * N + n0 + nc);
      tile[kr * 65 + nc] = v[0]; tile[kr * 65 + nc + 1] = v[1]; tile[kr * 65 + nc + 2] = v[2]; tile[kr * 65 + nc + 3] = v[3]; }
    __syncthreads();
    { const int n = tid >> 3, kc = (tid & 7) * 8; const int nn = n0 + n;
      const int orow = (mode == 0 ? nn : ((nn >> 2) * 8 + (nn & 3))) + row_off;
      u32x4 w;
      w.x = cvt_pk_bf16(tile[(kc + 0) * 65 + n], tile[(kc + 1) * 65 + n]); w.y = cvt_pk_bf16(tile[(kc + 2) * 65 + n], tile[(kc + 3) * 65 + n]);
      w.z = cvt_pk_bf16(tile[(kc + 4) * 65 + n], tile[(kc + 5) * 65 + n]); w.w = cvt_pk_bf16(tile[(kc + 6) * 65 + n], tile[(kc + 7) * 65 + n]);
      *(u32x4*)(Bt + (size_t)orow * K + k0 + kc) = w; }
    __syncthreads();
  }
  base += ntile;
}
__device__ __forceinline__ void prep_layer(float* tile, const Params& P, int layer) {
  bf16_t* Wb = (bf16_t*)(P.ws + WS_W); int base = 0; const int j = layer >> 1;
#pragma unroll 1
  for (int s = 0; s < 2; ++s) {
    const size_t off = (size_t)(layer * 2 + s) * DM * FF;
    bf16_t* gu = Wb + (s ? WE_GU1 : WE_GU0); bf16_t* dn = Wb + (s ? WE_D1 : WE_D0);
    prep_T(tile, P.ffn_g + off, DM, FF, gu, 1, 0, base);
    prep_T(tile, P.ffn_u + off, DM, FF, gu, 1, 4, base);
    prep_T(tile, P.ffn_d + off, FF, DM, dn, 0, 0, base);
  }
  if ((layer & 1) == 0) {
    prep_T(tile, P.m_dq + (size_t)j * 1024 * 384, 1024, 384, Wb + WE_DQKV, 0, 0, base);
    prep_T(tile, P.m_dkv + (size_t)j * 1024 * 320, 1024, 320, Wb + WE_DQKV, 0, 384, base);
    prep_T(tile, P.m_uq + (size_t)j * 384 * 1536, 384, 1536, Wb + WE_UQ, 0, 0, base);
    prep_T(tile, P.m_ukv + (size_t)j * 256 * 2048, 256, 2048, Wb + WE_UKV, 0, 0, base);
    prep_T(tile, P.m_wo + (size_t)j * 1024 * 1024, 1024, 1024, Wb + WE_MO, 0, 0, base);
    bf16_t* z = Wb + WE_DQKV + (size_t)704 * 1024;
    for (int i = blockIdx.x * 512 + tidx(); i < 64 * 1024 / 8; i += gridDim.x * 512) *(u32x4*)(z + (size_t)i * 8) = (u32x4){0u, 0u, 0u, 0u};
  } else {
    prep_T(tile, P.r_in + (size_t)j * 1024 * 6144, 1024, 6144, Wb + WE_RIN, 0, 0, base);
    prep_T(tile, P.r_wo + (size_t)j * 2048 * 1024, 2048, 1024, Wb + WE_RO, 0, 0, base);
  }
}
__device__ __forceinline__ void build_tables(const Params& P) {
  float* c64 = (float*)(P.ws + WS_TAB); float* s64 = c64 + 8192 * 32; float* c256 = s64 + 8192 * 32; float* s256 = c256 + 8192 * 128;
  const int lane = tidx() & 63, gw = blockIdx.x * 8 + (tidx() >> 6), nw = gridDim.x * 8;
  for (int pos = gw; pos < 8192; pos += nw)
  for (int k = lane; k < 160; k += 64) {
    double rb = (k < 32) ? 0.7498942093324559 : 0.930572040929699; int e = (k < 32) ? k : k - 32; double inv = 1.0;
#pragma unroll 1
    for (; e > 0; e >>= 1) { if (e & 1) inv *= rb; rb *= rb; }
    const double rev = (double)pos * inv * 0.15915494309189535;
    const float f = (float)(rev - rint(rev));
    const float c = __builtin_amdgcn_cosf(f), s = __builtin_amdgcn_sinf(f);
    if (k < 32) { c64[pos * 32 + k] = c; s64[pos * 32 + k] = s; } else { c256[pos * 128 + k - 32] = c; s256[pos * 128 + k - 32] = s; }
  }
}
__device__ __forceinline__ void rows_norm(int mode, const Params& P, const float* __restrict__ g1, const float* __restrict__ g2) {
  float* H = P.out; bf16_t* XN = (bf16_t*)(P.ws + WS_XN);
  const int lane = tidx() & 63, gw = blockIdx.x * 8 + (tidx() >> 6), nw = gridDim.x * 8;
  for (int row = gw; row < T_ALL; row += nw) {
    const float* src = (mode == 0) ? (row < T_GRP ? P.xp + (size_t)row * DM : P.xs + (size_t)(row - T_GRP) * DM) : H + (size_t)row * DM;
    f32x4 v[4]; float ss = 0.f;
#pragma unroll
    for (int i = 0; i < 4; ++i) { v[i] = *(const f32x4*)(src + i * 256 + lane * 4); ss += v[i][0] * v[i][0] + v[i][1] * v[i][1] + v[i][2] * v[i][2] + v[i][3] * v[i][3]; }
    ss = wave_sum(ss); const float rstd = rsqrtf(ss * (1.f / DM) + EPS);
    if (mode == 0) {
#pragma unroll
      for (int i = 0; i < 4; ++i) *(f32x4*)(H + (size_t)row * DM + i * 256 + lane * 4) = v[i]; }
    float ss2 = 0.f;
#pragma unroll
    for (int i = 0; i < 4; ++i) { const f32x4 gg = *(const f32x4*)(g1 + i * 256 + lane * 4); v[i] = v[i] * rstd * gg; ss2 += v[i][0] * v[i][0] + v[i][1] * v[i][1] + v[i][2] * v[i][2] + v[i][3] * v[i][3]; }
    if (mode == 2) {
#pragma unroll
      for (int i = 0; i < 4; ++i) *(f32x4*)(H + (size_t)row * DM + i * 256 + lane * 4) = v[i];
      if (g2 == nullptr) continue;
      ss2 = wave_sum(ss2); const float rstd2 = rsqrtf(ss2 * (1.f / DM) + EPS);
#pragma unroll
      for (int i = 0; i < 4; ++i) { const f32x4 gg = *(const f32x4*)(g2 + i * 256 + lane * 4); v[i] = v[i] * rstd2 * gg; }
    }
#pragma unroll
    for (int i = 0; i < 4; ++i) { u32x2 w; w.x = cvt_pk_bf16(v[i][0], v[i][1]); w.y = cvt_pk_bf16(v[i][2], v[i][3]); *(u32x2*)(XN + (size_t)row * DM + i * 256 + lane * 4) = w; }
  }
}
__device__ __forceinline__ void rows_mla_a(const Params& P, int j) {
  bf16_t* C = (bf16_t*)(P.ws + WS_S + S_CQKV); const float* qa = P.m_qa + j * 384; const float* kva = P.m_kva + j * 256;
  const int lane = tidx() & 63, gw = blockIdx.x * 8 + (tidx() >> 6), nw = gridDim.x * 8;
  for (int row = gw; row < T_ALL; row += nw) {
    bf16_t* r = C + (size_t)row * 768;
    unsigned q[3]; float ssq = 0.f;
#pragma unroll
    for (int i = 0; i < 3; ++i) { q[i] = *(const unsigned*)(r + i * 128 + lane * 2); const float a = bflo(q[i]), b = bfhi(q[i]); ssq += a * a + b * b; }
    const u32x2 kk = *(const u32x2*)(r + 384 + lane * 4);
    float kv[4] = {bflo(kk.x), bfhi(kk.x), bflo(kk.y), bfhi(kk.y)};
    float ssk = kv[0] * kv[0] + kv[1] * kv[1] + kv[2] * kv[2] + kv[3] * kv[3];
    ssq = wave_sum(ssq); ssk = wave_sum(ssk);
    const float rq = rsqrtf(ssq * (1.f / 384.f) + EPS), rk = rsqrtf(ssk * (1.f / 256.f) + EPS);
#pragma unroll
    for (int i = 0; i < 3; ++i) { const int c = i * 128 + lane * 2; *(unsigned*)(r + c) = cvt_pk_bf16(bflo(q[i]) * rq * qa[c], bfhi(q[i]) * rq * qa[c + 1]); }
    { const int c = lane * 4; u32x2 w; w.x = cvt_pk_bf16(kv[0] * rk * kva[c], kv[1] * rk * kva[c + 1]); w.y = cvt_pk_bf16(kv[2] * rk * kva[c + 2], kv[3] * rk * kva[c + 3]); *(u32x2*)(r + 384 + c) = w; }
  }
}
__device__ __forceinline__ void rows_mla_b(const Params& P, int j, int grp) {
  bf16_t* Qg = (bf16_t*)(P.ws + WS_S + S_Q); bf16_t* KVg = (bf16_t*)(P.ws + WS_S + S_KV); bf16_t* KPE = (bf16_t*)(P.ws + WS_S + S_KPE);
  const bf16_t* C = (const bf16_t*)(P.ws + WS_S + S_CQKV);
  const float* qn = P.m_qn + j * 192; const float* kn = P.m_kn + j * 192;
  const float* c64 = (const float*)(P.ws + WS_TAB); const float* s64 = c64 + 8192 * 32;
  const int lane = tidx() & 63, gw = blockIdx.x * 8 + (tidx() >> 6), nw = gridDim.x * 8;
  const int hd = lane >> 3, sub = lane & 7; const int seqmask = grp == 0 ? 4095 : 8191;
  for (int t = gw; t < T_GRP; t += nw) {
    const int pos = t & seqmask; const size_t grow = (size_t)grp * T_GRP + t;
    const float* cp = c64 + pos * 32 + (sub & 3) * 8; const float* sp = s64 + pos * 32 + (sub & 3) * 8;
    float cs[8], sn[8];
#pragma unroll
    for (int e = 0; e < 8; ++e) { cs[e] = cp[e]; sn[e] = sp[e]; }
    { bf16_t* qp = Qg + (size_t)t * 1536 + hd * 192 + sub * 8;
      float x[24]; float ss = 0.f;
#pragma unroll
      for (int c = 0; c < 3; ++c) { const u32x4 w = *(const u32x4*)(qp + 64 * c); const unsigned ww[4] = {w.x, w.y, w.z, w.w};
#pragma unroll
        for (int e = 0; e < 4; ++e) { x[c * 8 + 2 * e] = bflo(ww[e]); x[c * 8 + 2 * e + 1] = bfhi(ww[e]); } }
#pragma unroll
      for (int e = 0; e < 24; ++e) ss += x[e] * x[e];
      ss += __shfl_xor(ss, 1); ss += __shfl_xor(ss, 2); ss += __shfl_xor(ss, 4);
      const float rstd = rsqrtf(ss * (1.f / 192.f) + EPS);
#pragma unroll
      for (int c = 0; c < 3; ++c)
#pragma unroll
        for (int e = 0; e < 8; ++e) x[c * 8 + e] *= rstd * qn[c * 64 + sub * 8 + e];
#pragma unroll
      for (int e = 0; e < 8; ++e) { const float own = x[16 + e]; const float oth = __shfl_xor(own, 4);
        x[16 + e] = (sub < 4) ? (own * cs[e] - oth * sn[e]) : (own * cs[e] + oth * sn[e]); }
#pragma unroll
      for (int c = 0; c < 3; ++c) { u32x4 w; w.x = cvt_pk_bf16(x[c * 8], x[c * 8 + 1]); w.y = cvt_pk_bf16(x[c * 8 + 2], x[c * 8 + 3]); w.z = cvt_pk_bf16(x[c * 8 + 4], x[c * 8 + 5]); w.w = cvt_pk_bf16(x[c * 8 + 6], x[c * 8 + 7]);
        *(u32x4*)(qp + 64 * c) = w; }
    }
    { bf16_t* kp = KVg + (size_t)t * 2048 + hd * 256 + sub * 8; const bf16_t* pp = C + grow * 768 + 640 + sub * 8;
      float x[24]; float ss = 0.f;
#pragma unroll
      for (int c = 0; c < 3; ++c) { const u32x4 w = (c < 2) ? *(const u32x4*)(kp + 64 * c) : *(const u32x4*)pp; const unsigned ww[4] = {w.x, w.y, w.z, w.w};
#pragma unroll
        for (int e = 0; e < 4; ++e) { x[c * 8 + 2 * e] = bflo(ww[e]); x[c * 8 + 2 * e + 1] = bfhi(ww[e]); } }
#pragma unroll
      for (int e = 0; e < 24; ++e) ss += x[e] * x[e];
      ss += __shfl_xor(ss, 1); ss += __shfl_xor(ss, 2); ss += __shfl_xor(ss, 4);
      const float rstd = rsqrtf(ss * (1.f / 192.f) + EPS);
#pragma unroll
      for (int c = 0; c < 3; ++c)
#pragma unroll
        for (int e = 0; e < 8; ++e) x[c * 8 + e] *= rstd * kn[c * 64 + sub * 8 + e];
#pragma unroll
      for (int e = 0; e < 8; ++e) { const float own = x[16 + e]; const float oth = __shfl_xor(own, 4);
        x[16 + e] = (sub < 4) ? (own * cs[e] - oth * sn[e]) : (own * cs[e] + oth * sn[e]); }
#pragma unroll
      for (int c = 0; c < 2; ++c) { u32x4 w; w.x = cvt_pk_bf16(x[c * 8], x[c * 8 + 1]); w.y = cvt_pk_bf16(x[c * 8 + 2], x[c * 8 + 3]); w.z = cvt_pk_bf16(x[c * 8 + 4], x[c * 8 + 5]); w.w = cvt_pk_bf16(x[c * 8 + 6], x[c * 8 + 7]);
        *(u32x4*)(kp + 64 * c) = w; }
      { u32x4 w; w.x = cvt_pk_bf16(x[16], x[17]); w.y = cvt_pk_bf16(x[18], x[19]); w.z = cvt_pk_bf16(x[20], x[21]); w.w = cvt_pk_bf16(x[22], x[23]);
        *(u32x4*)(KPE + (size_t)t * 512 + hd * 64 + sub * 8) = w; }
    }
  }
}
__device__ __forceinline__ void rows_ret_gn(const Params& P, int j) {
  bf16_t* Y = (bf16_t*)(P.ws + WS_S + S_RQ); const bf16_t* OF = (const bf16_t*)(P.ws + WS_S + S_OF); const bf16_t* OB = (const bf16_t*)(P.ws + WS_S + S_OB); const bf16_t* RG = (const bf16_t*)(P.ws + WS_S + S_RG);
  const float* gn = P.r_gn + j * 2048;
  const int lane = tidx() & 63, gw = blockIdx.x * 8 + (tidx() >> 6), nw = gridDim.x * 8;
  for (int task = gw; task < T_GRP * 4; task += nw) {
    const size_t off = (size_t)(task >> 2) * 2048 + (task & 3) * 512 + lane * 8;
    const size_t offo = ((size_t)((task & 3) * 16 + (lane >> 2)) * T_GRP + (task >> 2)) * 32 + (lane & 3) * 8;
    const u32x4 a = *(const u32x4*)(OF + offo), b = *(const u32x4*)(OB + offo), g = *(const u32x4*)(RG + off);
    const unsigned aw[4] = {a.x, a.y, a.z, a.w}, bw[4] = {b.x, b.y, b.z, b.w}, gw4[4] = {g.x, g.y, g.z, g.w};
    float o[8]; float sm = 0.f;
#pragma unroll
    for (int e = 0; e < 4; ++e) { o[2 * e] = bflo(aw[e]) + bflo(bw[e]); o[2 * e + 1] = bfhi(aw[e]) + bfhi(bw[e]); sm += o[2 * e] + o[2 * e + 1]; }
    sm = wave_sum(sm); const float mu = sm * (1.f / 512.f);
    float vs = 0.f;
#pragma unroll
    for (int e = 0; e < 8; ++e) { o[e] -= mu; vs += o[e] * o[e]; }
    vs = wave_sum(vs); const float rstd = rsqrtf(vs * (1.f / 512.f) + EPS);
    const float* gp = gn + (task & 3) * 512 + lane * 8;
    float y[8];
#pragma unroll
    for (int e = 0; e < 4; ++e) { y[2 * e] = o[2 * e] * rstd * gp[2 * e] * bflo(gw4[e]); y[2 * e + 1] = o[2 * e + 1] * rstd * gp[2 * e + 1] * bfhi(gw4[e]); }
    u32x4 w; w.x = cvt_pk_bf16(y[0], y[1]); w.y = cvt_pk_bf16(y[2], y[3]); w.z = cvt_pk_bf16(y[4], y[5]); w.w = cvt_pk_bf16(y[6], y[7]);
    *(u32x4*)(Y + off) = w;
  }
}

#define GRID_BARRIER(wsptr) do { ++nbar; __builtin_amdgcn_fence(__ATOMIC_RELEASE, "agent"); __syncthreads(); \
    if (threadIdx.x == 0) { unsigned* bar_ = (unsigned*)((wsptr) + WS_BAR); __hip_atomic_fetch_add(bar_, 1u, __ATOMIC_RELAXED, __HIP_MEMORY_SCOPE_AGENT); \
      const unsigned target_ = nbar * (unsigned)G; while (__hip_atomic_load(bar_, __ATOMIC_RELAXED, __HIP_MEMORY_SCOPE_AGENT) < target_) __builtin_amdgcn_s_sleep(2); } \
    __syncthreads(); __builtin_amdgcn_fence(__ATOMIC_ACQUIRE, "agent"); } while (0)
constexpr int PH_PER_LAYER = 19, N_PHASES = 1 + 4 * PH_PER_LAYER;
__global__ void __launch_bounds__(512, 2) mega(Params Pk) {
  extern __shared__ __attribute__((aligned(16))) unsigned char lds_raw[];
  cg::grid_group grid = cg::this_grid();
  LAS unsigned char* L = (LAS unsigned char*)lds_raw;
  const int G = gridDim.x;
  const int ph_lo = Pk.ph_lo, ph_hi = Pk.ph_hi;
  if (ph_lo < 0) grid.sync();
  unsigned nbar = 0;
#pragma unroll 1
  for (int ph = ph_lo; ph < ph_hi; ++ph) {
#if defined(__HIP_DEVICE_COMPILE__)
    const __attribute__((address_space(4))) Params* pp = (const __attribute__((address_space(4))) Params*)__builtin_amdgcn_kernarg_segment_ptr();
    asm volatile("" : "+s"(pp));
    const Params P = *pp;
#else
    const Params P = Pk;
#endif
    bf16_t* Wb = (bf16_t*)(P.ws + WS_W); bf16_t* XN = (bf16_t*)(P.ws + WS_XN); unsigned char* SB = P.ws + WS_S;
    float* H = P.out;
    if (ph == 0) {
      prep_layer((float*)lds_raw, P, 0); build_tables(P); rows_norm(0, P, P.norm_g, nullptr);
    } else {
      const int layer = (ph - 1) / PH_PER_LAYER, p = (ph - 1) % PH_PER_LAYER, j = layer >> 1; const bool is_ret = layer & 1;
      const float* ng = P.norm_g + layer * 4 * DM;
      int op = 0, grp = 0, s = 0;
      if (p == 0 || p == 16) { op = 0; s = (p == 16); }
      else if (p == 1 || p == 17) { op = 1; s = (p == 17); }
      else if (p == 2 || p == 15) op = 2;
      else if (p == 18) op = 3;
      else if (!is_ret) {
        if (p == 3) op = 4; else if (p == 4) op = 5; else if (p == 14) op = 1;
        else { grp = (p - 5) / 3; const int sub = (p - 5) % 3; op = sub == 0 ? 4 : (sub == 1 ? 6 : 7); }
      } else { grp = (p - 3) / 4; const int sub = (p - 3) % 4; op = sub == 0 ? 8 : (sub == 1 ? 9 : (sub == 2 ? 10 : 1)); }
      const int seqlen = grp == 0 ? 4096 : 8192, nseq = grp == 0 ? 4 : 2;

      if (op == 0) {
        pg8::Gemm g{XN, Wb + (s ? WE_GU1 : WE_GU0), T_ALL, 2 * FF, DM, DM}; pg8::StaticOrder S; S.init(T_ALL, 2 * FF, G, blockIdx.x);
        pg8::EpiSwiGLU E{(bf16_t*)(SB + S_ACT)}; pg8::gemm_phase(L, g, S, E);
      } else if (op == 1) {
        pg8::Gemm g; float* Hh = H; float alpha = 0.5f;
        if (p == 1 || p == 17) g = pg8::Gemm{(const bf16_t*)(SB + S_ACT), Wb + (s ? WE_D1 : WE_D0), T_ALL, DM, FF, FF};
        else if (!is_ret) { g = pg8::Gemm{XN, Wb + WE_MO, T_ALL, DM, DM, DM}; alpha = 1.f; }
        else { g = pg8::Gemm{(const bf16_t*)(SB + S_RQ), Wb + WE_RO, T_GRP, DM, 2048, 2048}; alpha = 1.f; Hh = H + (size_t)grp * T_GRP * DM; }
        pg8::StaticOrder S; S.init(g.M, DM, G, blockIdx.x);
        pg8::EpiResid E{Hh, alpha}; pg8::gemm_phase(L, g, S, E);
      } else if (op == 2) {
        rows_norm(1, P, ng + (p == 2 ? 1 : 2) * DM, nullptr);
      } else if (op == 3) {
        if (layer < 3) prep_layer((float*)lds_raw, P, layer + 1);
        rows_norm(2, P, ng + 3 * DM, layer < 3 ? ng + 4 * DM : nullptr);
      } else if (op == 4) {
        const int ng2 = (p == 3) ? 1 : 2;
#pragma unroll 1
        for (int gi = 0; gi < ng2; ++gi) {
          pg8::Gemm g; pg8::EpiBf16 E;
          if (p == 3) { g = pg8::Gemm{XN, Wb + WE_DQKV, T_ALL, 768, DM, DM}; E = pg8::EpiBf16{(bf16_t*)(SB + S_CQKV), 768}; }
          else if (gi == 0) { g = pg8::Gemm{(const bf16_t*)(SB + S_CQKV) + (size_t)grp * T_GRP * 768, Wb + WE_UQ, T_GRP, 1536, 384, 768}; E = pg8::EpiBf16{(bf16_t*)(SB + S_Q), 1536}; }
          else { g = pg8::Gemm{(const bf16_t*)(SB + S_CQKV) + (size_t)grp * T_GRP * 768 + 384, Wb + WE_UKV, T_GRP, 2048, 256, 768}; E = pg8::EpiBf16{(bf16_t*)(SB + S_KV), 2048}; }
          pg8::StaticOrder S; S.init(g.M, g.N, G, blockIdx.x);
          pg8::gemm_phase(L, g, S, E);
        }
      } else if (op == 5) {
        rows_mla_a(P, j);
      } else if (op == 6) {
        rows_mla_b(P, j, grp);
      } else if (op == 7) {
        const int nqb = seqlen >> 8; const int nunits = nseq * 8 * nqb;
        const bf16_t* Qg = (const bf16_t*)(SB + S_Q); const bf16_t* KVg = (const bf16_t*)(SB + S_KV); const bf16_t* KPE = (const bf16_t*)(SB + S_KPE);
#pragma unroll 1
        for (int u = blockIdx.x; u < nunits; u += G) {
          const int qb = u % nqb, hd = (u / nqb) & 7, sq = u / (nqb * 8);
          const size_t r0 = (size_t)sq * seqlen;
          att::attn_unit(Qg + (r0 + (size_t)qb * 256) * 1536 + hd * 192, KVg + r0 * 2048 + hd * 256, KPE + r0 * 512 + hd * 64,
                         XN + ((size_t)grp * T_GRP + r0 + (size_t)qb * 256) * DM + hd * 128, seqlen, (char*)lds_raw, (int)(uintptr_t)L);
        }
      } else if (op == 8) {
        const float* c256 = (const float*)(P.ws + WS_TAB) + 2 * 8192 * 32;
        pg8::Gemm g{XN + (size_t)grp * T_GRP * DM, Wb + WE_RIN, T_GRP, 6144, DM, DM}; pg8::StaticOrder S; S.init(T_GRP, 6144, G, blockIdx.x);
        pg8::EpiRet E{(bf16_t*)(SB + S_RQ), (bf16_t*)(SB + S_RK), (bf16_t*)(SB + S_RKT), (bf16_t*)(SB + S_RV), (bf16_t*)(SB + S_RG), c256, c256 + 8192 * 128, seqlen - 1};
        pg8::gemm_phase(L, g, S, E);
      } else if (op == 9) {
        const int nitems = nseq * 4 * 2 * 16;
#pragma unroll 1
        for (int itx = blockIdx.x; itx < nitems; itx += G) {
          const int sl = itx & 15, dir = (itx >> 4) & 1, hd = (itx >> 5) & 3, sq = itx >> 7;
          const float dec = (dir ? P.r_db : P.r_df)[j * 4 + hd];
          const float xg = __builtin_amdgcn_exp2f(dec * 1.4426950408889634f);
          const float ser = xg * (1.f + xg * (0.5f + xg * (0.33333334f + xg * (0.25f + xg * (0.2f + xg * (0.16666667f + xg * (0.14285715f + xg * 0.125f)))))));
          const float lg2 = -ser * 1.4426950408889634f;
          ret::scan_item(L, (const bf16_t*)(SB + S_RQ), (const bf16_t*)(SB + S_RK), (const bf16_t*)(SB + S_RKT), (const bf16_t*)(SB + S_RV),
                         (bf16_t*)(SB + (dir ? S_OB : S_OF)), seqlen, sq, hd, dir, sl, lg2);
        }
      } else if (op == 10) {
        rows_ret_gn(P, j);
      }
    }
    if (ph + 1 < ph_hi) GRID_BARRIER(P.ws);
  }
#ifdef DBG_N
  {
    unsigned char* wsb = Pk.ws; float* Hh = Pk.out; const unsigned* XNw = (const unsigned*)(wsb + WS_XN);
    GRID_BARRIER(wsb);
    unsigned hsh = 0, nanc = 0; const size_t nth = (size_t)G * 512, gt = (size_t)blockIdx.x * 512 + threadIdx.x;
#if DBG_WHAT & 1
    for (size_t i = gt; i < (size_t)T_ALL * DM; i += nth) { const unsigned u = __float_as_uint(Hh[i]); hsh += u * 2654435761u + 1u; if ((u & 0x7f800000u) == 0x7f800000u) ++nanc; }
#endif
#if DBG_WHAT & 2
    for (size_t i = gt; i < (size_t)T_ALL * DM / 2; i += nth) { const unsigned u = XNw[i]; hsh += u * 2246822519u + 1u; if ((u & 0x7f800000u) == 0x7f800000u || (u & 0x7f80u) == 0x7f80u) ++nanc; }
#endif
#if DBG_WHAT & 4
    { const unsigned* Sw = (const unsigned*)(wsb + WS_S + DBG_OFF); for (size_t i = gt; i < (size_t)DBG_LEN / 4; i += nth) { const unsigned u = Sw[i]; hsh += u * 3266489917u + 1u; if ((u & 0x7f800000u) == 0x7f800000u || (u & 0x7f80u) == 0x7f80u) ++nanc; } }
#endif
    unsigned* cnt = (unsigned*)(wsb + WS_BAR) + 64;
    atomicAdd(cnt, hsh); atomicAdd(cnt + 1, nanc);
    GRID_BARRIER(wsb);
    const unsigned th = __hip_atomic_load(cnt, __ATOMIC_RELAXED, __HIP_MEMORY_SCOPE_AGENT), tn = __hip_atomic_load(cnt + 1, __ATOMIC_RELAXED, __HIP_MEMORY_SCOPE_AGENT);
    const float v = (tn ? 30.f : 10.f) + (float)(th & 1023u) * 1e-3f;
    for (size_t i = gt; i < (size_t)T_ALL * DM; i += nth) Hh[i] = v;
  }
#endif
}

extern "C" void kernel_launch(void* const* d_in, const int* in_sizes, int n_in, void* d_out, int out_size, void* d_ws, size_t ws_size, hipStream_t stream) {
  static int grid_blocks = 0;
  if (grid_blocks == 0) {
    if (n_in != 20 || out_size != T_ALL * DM || ws_size < WS_END) { fprintf(stderr, "kernel_launch: unexpected shapes n_in %d out %d ws %zu (need %zu)\n", n_in, out_size, ws_size, (size_t)WS_END); }
    int dev = 0, cus = 0, per_cu = 0;
    (void)hipGetDevice(&dev);
    (void)hipDeviceGetAttribute(&cus, hipDeviceAttributeMultiprocessorCount, dev);
    if (hipFuncSetAttribute((const void*)mega, hipFuncAttributeMaxDynamicSharedMemorySize, LDS_BYTES) != hipSuccess) fprintf(stderr, "kernel_launch: hipFuncSetAttribute failed\n");
    if (hipOccupancyMaxActiveBlocksPerMultiprocessor(&per_cu, (const void*)mega, 512, LDS_BYTES) != hipSuccess || per_cu < 1) { fprintf(stderr, "kernel_launch: occupancy query gave %d\n", per_cu); per_cu = 1; }
    (void)hipGetLastError();
    grid_blocks = cus * per_cu;
  }
  Params p{};
  p.xp = (const float*)d_in[0]; p.xs = (const float*)d_in[1]; p.norm_g = (const float*)d_in[2]; p.ffn_g = (const float*)d_in[3]; p.ffn_u = (const float*)d_in[4]; p.ffn_d = (const float*)d_in[5];
  p.m_dq = (const float*)d_in[6]; p.m_qa = (const float*)d_in[7]; p.m_uq = (const float*)d_in[8]; p.m_dkv = (const float*)d_in[9]; p.m_kva = (const float*)d_in[10]; p.m_ukv = (const float*)d_in[11];
  p.m_qn = (const float*)d_in[12]; p.m_kn = (const float*)d_in[13]; p.m_wo = (const float*)d_in[14];
  p.r_in = (const float*)d_in[15]; p.r_df = (const float*)d_in[16]; p.r_db = (const float*)d_in[17]; p.r_gn = (const float*)d_in[18]; p.r_wo = (const float*)d_in[19];
  p.out = (float*)d_out; p.ws = (unsigned char*)d_ws; p.ph_lo = 0; p.ph_hi = N_PHASES;
#ifdef DBG_N
  p.ph_hi = DBG_N;
#endif
  (void)hipMemsetAsync((char*)d_ws + WS_BAR, 0, 4096, stream);
  void* args[] = {&p};
  hipError_t e = hipLaunchCooperativeKernel((const void*)mega, dim3(grid_blocks), dim3(512), args, LDS_BYTES, stream);
  if (e != hipSuccess) fprintf(stderr, "kernel_launch: cooperative launch failed: %s (grid %d)\n", hipGetErrorString(e), grid_blocks);
}
```

```cpp
#include <hip/hip_runtime.h>
#include <hip/hip_cooperative_groups.h>
#include <cstdio>
#include <cstdint>
#include <cmath>
namespace cg = cooperative_groups;

#define LAS __attribute__((address_space(3)))
typedef unsigned short bf16_t;
typedef short bf16x8 __attribute__((ext_vector_type(8)));
typedef short s16x4 __attribute__((ext_vector_type(4)));
typedef float f32x4 __attribute__((ext_vector_type(4)));
typedef float f32x16 __attribute__((ext_vector_type(16)));
typedef unsigned u32x4 __attribute__((ext_vector_type(4)));
typedef unsigned u32x2 __attribute__((ext_vector_type(2)));

constexpr int T_ALL = 49152, T_GRP = 16384, DM = 1024, FF = 2816;
constexpr float EPS = 1e-6f;
constexpr int LDS_BYTES = 147456;
constexpr size_t MiB = 1u << 20;
constexpr size_t WS_W = 0;
constexpr size_t WS_TAB = 56 * MiB;
constexpr size_t WS_XN = 66 * MiB;
constexpr size_t WS_S = 162 * MiB;
constexpr size_t WS_BAR = WS_S + 352 * MiB;
constexpr size_t WS_END = WS_BAR + 16384;
constexpr size_t WE_GU0 = 0, WE_D0 = WE_GU0 + (size_t)5632 * 1024, WE_GU1 = WE_D0 + (size_t)1024 * 2816, WE_D1 = WE_GU1 + (size_t)5632 * 1024,
                 WE_MIX = WE_D1 + (size_t)1024 * 2816;
constexpr size_t WE_DQKV = WE_MIX, WE_UQ = WE_DQKV + (size_t)768 * 1024, WE_UKV = WE_UQ + (size_t)1536 * 384, WE_MO = WE_UKV + (size_t)2048 * 256;
constexpr size_t WE_RIN = WE_MIX, WE_RO = WE_RIN + (size_t)6144 * 1024;
constexpr size_t S_ACT = 0;
constexpr size_t S_CQKV = 0, S_Q = 72 * MiB, S_KV = 120 * MiB, S_KPE = 184 * MiB;
constexpr size_t S_RQ = 0, S_RK = 32 * MiB, S_RKT = 64 * MiB, S_RV = 96 * MiB, S_RG = 160 * MiB, S_OF = 224 * MiB, S_OB = 288 * MiB;

struct Params {
  const float* xp; const float* xs; const float* norm_g; const float* ffn_g; const float* ffn_u; const float* ffn_d;
  const float* m_dq; const float* m_qa; const float* m_uq; const float* m_dkv; const float* m_kva; const float* m_ukv;
  const float* m_qn; const float* m_kn; const float* m_wo;
  const float* r_in; const float* r_df; const float* r_db; const float* r_gn; const float* r_wo;
  float* out; unsigned char* ws;
  int ph_lo, ph_hi;
};

typedef __bf16 bf16x2_t __attribute__((ext_vector_type(2)));
typedef float f32x2_t __attribute__((ext_vector_type(2)));
__device__ __forceinline__ unsigned cvt_pk_bf16(float lo, float hi) { const f32x2_t v = {lo, hi}; const bf16x2_t b = __builtin_convertvector(v, bf16x2_t); return __builtin_bit_cast(unsigned, b); }
__device__ __forceinline__ float bflo(unsigned w) { return __uint_as_float(w << 16); }
__device__ __forceinline__ float bfhi(unsigned w) { return __uint_as_float(w & 0xffff0000u); }
__device__ __forceinline__ float bf2f(unsigned short u) { return __uint_as_float(((unsigned)u) << 16); }
__device__ __forceinline__ unsigned short f2bf(float f) { return (unsigned short)(cvt_pk_bf16(f, 0.f) & 0xffffu); }
__device__ __forceinline__ float wave_sum(float v) {
#pragma unroll
  for (int o = 32; o > 0; o >>= 1) v += __shfl_xor(v, o);
  return v;
}
__device__ __forceinline__ int tidx() { int t = threadIdx.x; asm volatile("" : "+v"(t)); return t; }
__device__ __forceinline__ float silu_f(float x) { return x * __builtin_amdgcn_rcpf(1.f + __builtin_amdgcn_exp2f(-1.4426950408889634f * x)); }

namespace pg8 {
constexpr int BM = 256, BK = 64, HALF = 128, HTB = HALF * BK * 2, NXCD = 8, WGM = 8;
__host__ __device__ __forceinline__ int lds_byte(int r, int c) { const int st = (r >> 4) * 2 + (c >> 5), rr = r & 15, cc = c & 31, ob = rr * 64 + cc * 2; return st * 1024 + (ob ^ (((ob >> 9) & 1) << 5)); }
__host__ __device__ __forceinline__ void stage_rc(int b, int& R, int& C) { const int st = b / 1024, sb = b % 1024, swz = sb ^ (((sb >> 9) & 1) << 5); R = (st >> 1) * 16 + swz / 64; C = (st & 1) * 32 + (swz % 64) / 2; }
__host__ __device__ __forceinline__ int perm32(int rho) { const int n = rho >> 4, i = rho & 15; return 8 * (i >> 2) + 4 * n + (i & 3); }
struct Unit { int pm, pn; };
struct Gemm { const bf16_t* A; const bf16_t* Bt; int M, N, K, lda; };
struct StaticOrder {
  int nM, nN, nwg, G, c;
  __device__ void init(int M, int N, int G_, int c_) { nM = M / BM; nN = N / BM; nwg = nM * nN; G = G_; c = c_; }
  __device__ bool next(int i, Unit& u) const {
    const long L = (long)i * G + c; if (L >= nwg) return false;
    int wgid = (int)L; { const int q = nwg / NXCD, r = nwg % NXCD, xcd = wgid % NXCD, off = wgid / NXCD; wgid = (xcd < r ? xcd * (q + 1) : r * (q + 1) + (xcd - r) * q) + off; }
    const int nig = WGM * nN, gid = wgid / nig, fm = gid * WGM, gsz = (nM - fm) < WGM ? (nM - fm) : WGM;
    u.pm = fm + ((wgid % nig) % gsz); u.pn = (wgid % nig) / gsz; return true;
  }
};
template <class Epi>
__device__ __forceinline__ void gemm_phase(LAS unsigned char* lds, const Gemm g, const StaticOrder& S, const Epi& E) {
  const int tid = tidx(), wid = __builtin_amdgcn_readfirstlane(tid >> 6), lane = tid & 63, wr = wid >> 2, wc = wid & 3, fr = lane & 15, fq = lane >> 4;
  const int K = g.K, nt = K / BK, lda = g.lda;
  unsigned voffA[2], voffB[2];
#pragma unroll
  for (int i = 0; i < 2; ++i) { int R, C; stage_rc(tid * 16 + i * 8192, R, C); const int Rb = (R & ~31) + perm32(R & 31);
    voffA[i] = (unsigned)(R * lda + C) * 2u; voffB[i] = (unsigned)(Rb * K + C) * 2u; }
  const size_t kstep = (size_t)(BK * 2);
  const size_t hstepA = (size_t)HALF * lda * 2, hstepB = (size_t)HALF * K * 2;
  const size_t tstepA = 2 * hstepA, tstepB = 2 * hstepB;
  const unsigned ldsw = (unsigned)wid * 1024u;
  const int aoff = lds_byte(wr * 64 + fr, fq * 8), boff = lds_byte(wc * 32 + fr, fq * 8);
#define PG8_SA(b, h) (((b) * 2 + (h)) * HTB)
#define PG8_SB(b, h) ((4 + (b) * 2 + (h)) * HTB)
#define PG8_STAGE(bufoff, gbase, voff) do { _Pragma("unroll") for (int _i = 0; _i < 2; ++_i) \
    __builtin_amdgcn_global_load_lds((const unsigned*)((const char*)(gbase) + (voff)[_i]), (LAS unsigned*)(lds + (bufoff) + ldsw + _i * 8192), 16, 0, 0); } while (0)
#define PG8_LDA(dst, b, h) do { _Pragma("unroll") for (int m = 0; m < 4; ++m) _Pragma("unroll") for (int k = 0; k < 2; ++k) dst[m][k] = *(const LAS bf16x8*)(lds + PG8_SA(b, h) + aoff + m * 2048 + k * 1024); } while (0)
#define PG8_LDB(dst, b, h) do { _Pragma("unroll") for (int n = 0; n < 2; ++n) _Pragma("unroll") for (int k = 0; k < 2; ++k) dst[n][k] = *(const LAS bf16x8*)(lds + PG8_SB(b, h) + boff + n * 2048 + k * 1024); } while (0)
#define PG8_MMA(ai, bj, At, Bt) do { __builtin_amdgcn_s_setprio(1); _Pragma("unroll") for (int m = 0; m < 4; ++m) _Pragma("unroll") for (int n = 0; n < 2; ++n) _Pragma("unroll") for (int k = 0; k < 2; ++k) \
    acc[ai][bj][m][n] = __builtin_amdgcn_mfma_f32_16x16x32_bf16(Bt[n][k], At[m][k], acc[ai][bj][m][n], 0, 0, 0); __builtin_amdgcn_s_setprio(0); } while (0)
#define PG8_WAIT_V(n) asm volatile("s_waitcnt vmcnt(" #n ")" ::: "memory")
#define PG8_WAIT_L(n) asm volatile("s_waitcnt lgkmcnt(" #n ")" ::: "memory")
#define PG8_BAR __builtin_amdgcn_s_barrier()
#define PG8_SCHED __builtin_amdgcn_sched_barrier(0)
  Unit cur, nxt; int ui = 0;
  if (!S.next(0, cur)) return;
  f32x4 acc[2][2][4][2];
#pragma unroll
  for (int a = 0; a < 2; ++a)
#pragma unroll
    for (int b = 0; b < 2; ++b)
#pragma unroll
      for (int m = 0; m < 4; ++m)
#pragma unroll
        for (int n = 0; n < 2; ++n) acc[a][b][m][n] = (f32x4){0.f, 0.f, 0.f, 0.f};
  bf16x8 At[4][2], B0[2][2], B1[2][2];
  const char* cA = (const char*)g.A + (size_t)cur.pm * tstepA; const char* cB = (const char*)g.Bt + (size_t)cur.pn * tstepB;
  PG8_STAGE(PG8_SB(0, 0), cB, voffB); PG8_STAGE(PG8_SB(0, 1), cB + hstepB, voffB); PG8_STAGE(PG8_SA(0, 0), cA, voffA); PG8_STAGE(PG8_SA(0, 1), cA + hstepA, voffA);
  if (wr == 1) PG8_BAR;
  PG8_WAIT_V(2); PG8_BAR;
  PG8_STAGE(PG8_SB(1, 0), cB + kstep, voffB); PG8_STAGE(PG8_SA(1, 0), cA + kstep, voffA); PG8_STAGE(PG8_SB(1, 1), cB + hstepB + kstep, voffB);
  PG8_WAIT_V(6); PG8_BAR;
  for (;;) {
    const bool has_next = S.next(ui + 1, nxt);
    const char* nA = has_next ? (const char*)g.A + (size_t)nxt.pm * tstepA : cA; const char* nB = has_next ? (const char*)g.Bt + (size_t)nxt.pn * tstepB : cB;
    for (int t = 0; t < nt; t += 2) {
      const bool last = (t == nt - 2);
      const char* a1 = cA + (size_t)(t + 1) * kstep;
      const char* a2 = last ? nA : cA + (size_t)(t + 2) * kstep; const char* b2 = last ? nB : cB + (size_t)(t + 2) * kstep;
      const char* a3 = a2 + kstep; const char* b3 = b2 + kstep;
      PG8_LDB(B0, 0, 0); PG8_LDB(B1, 0, 1); PG8_SCHED; PG8_LDA(At, 0, 0); PG8_STAGE(PG8_SA(1, 1), a1 + hstepA, voffA);
      PG8_WAIT_V(8); PG8_WAIT_L(0); PG8_BAR; PG8_MMA(0, 0, At, B0); PG8_MMA(0, 1, At, B1); PG8_BAR; PG8_SCHED;
      PG8_LDA(At, 0, 1); PG8_STAGE(PG8_SB(0, 0), b2, voffB); PG8_STAGE(PG8_SB(0, 1), b2 + hstepB, voffB); PG8_STAGE(PG8_SA(0, 0), a2, voffA);
      PG8_WAIT_V(8); PG8_WAIT_L(0); PG8_BAR; PG8_MMA(1, 0, At, B0); PG8_MMA(1, 1, At, B1); PG8_BAR; PG8_SCHED;
      PG8_LDB(B0, 1, 0); PG8_LDB(B1, 1, 1); PG8_SCHED; PG8_LDA(At, 1, 0); PG8_STAGE(PG8_SA(0, 1), a2 + hstepA, voffA);
      PG8_WAIT_V(8); PG8_WAIT_L(0); PG8_BAR; PG8_MMA(0, 0, At, B0); PG8_MMA(0, 1, At, B1); PG8_BAR; PG8_SCHED;
      PG8_LDA(At, 1, 1); PG8_STAGE(PG8_SB(1, 0), b3, voffB); PG8_STAGE(PG8_SB(1, 1), b3 + hstepB, voffB); PG8_STAGE(PG8_SA(1, 0), a3, voffA);
      PG8_WAIT_V(8); PG8_WAIT_L(0); PG8_BAR; PG8_MMA(1, 0, At, B0); PG8_MMA(1, 1, At, B1); PG8_BAR; PG8_SCHED;
    }
    if (wr == 0) PG8_BAR;
    E(acc, cur, wr, wc, fr, fq);
    if (!has_next) break;
#pragma unroll
    for (int a = 0; a < 2; ++a)
#pragma unroll
      for (int b = 0; b < 2; ++b)
#pragma unroll
        for (int m = 0; m < 4; ++m)
#pragma unroll
          for (int n = 0; n < 2; ++n) acc[a][b][m][n] = (f32x4){0.f, 0.f, 0.f, 0.f};
    cur = nxt; cA = nA; cB = nB; ++ui;
    if (wr == 1) PG8_BAR;
  }
  PG8_WAIT_V(0);
  PG8_BAR;
#undef PG8_SA
#undef PG8_SB
#undef PG8_STAGE
#undef PG8_LDA
#undef PG8_LDB
#undef PG8_MMA
#undef PG8_WAIT_V
#undef PG8_WAIT_L
#undef PG8_BAR
#undef PG8_SCHED
}

struct EpiBf16 {
  bf16_t* O; int ldc;
  __device__ __forceinline__ void operator()(const f32x4 (&acc)[2][2][4][2], const Unit& u, int wr, int wc, int fr, int fq) const {
    const int row0 = u.pm * BM + wr * 64 + fr, col0 = u.pn * BM + wc * 32 + 8 * fq;
#pragma unroll
    for (int ai = 0; ai < 2; ++ai)
#pragma unroll
      for (int m = 0; m < 4; ++m) { bf16_t* rowp = O + (size_t)(row0 + ai * HALF + m * 16) * ldc + col0;
#pragma unroll
        for (int bj = 0; bj < 2; ++bj) { const f32x4 v0 = acc[ai][bj][m][0], v1 = acc[ai][bj][m][1];
          u32x4 w; w.x = cvt_pk_bf16(v0[0], v0[1]); w.y = cvt_pk_bf16(v0[2], v0[3]); w.z = cvt_pk_bf16(v1[0], v1[1]); w.w = cvt_pk_bf16(v1[2], v1[3]);
          *(u32x4*)(rowp + bj * HALF) = w; } }
  }
};
struct EpiSwiGLU {
  bf16_t* O;
  __device__ __forceinline__ void operator()(const f32x4 (&acc)[2][2][4][2], const Unit& u, int wr, int wc, int fr, int fq) const {
    const int row0 = u.pm * BM + wr * 64 + fr, col0 = u.pn * 128 + wc * 16 + 4 * fq;
#pragma unroll
    for (int ai = 0; ai < 2; ++ai)
#pragma unroll
      for (int m = 0; m < 4; ++m) { bf16_t* rowp = O + (size_t)(row0 + ai * HALF + m * 16) * FF + col0;
#pragma unroll
        for (int bj = 0; bj < 2; ++bj) { const f32x4 gt = acc[ai][bj][m][0], up = acc[ai][bj][m][1];
          u32x2 w; w.x = cvt_pk_bf16(silu_f(gt[0]) * up[0], silu_f(gt[1]) * up[1]); w.y = cvt_pk_bf16(silu_f(gt[2]) * up[2], silu_f(gt[3]) * up[3]);
          *(u32x2*)(rowp + bj * 64) = w; } }
  }
};
struct EpiResid {
  float* H; float alpha;
  __device__ __forceinline__ void operator()(const f32x4 (&acc)[2][2][4][2], const Unit& u, int wr, int wc, int fr, int fq) const {
    const int row0 = u.pm * BM + wr * 64 + fr, col0 = u.pn * BM + wc * 32 + 8 * fq;
#pragma unroll
    for (int ai = 0; ai < 2; ++ai)
#pragma unroll
      for (int m = 0; m < 4; ++m) { float* rowp = H + (size_t)(row0 + ai * HALF + m * 16) * DM + col0;
#pragma unroll
        for (int bj = 0; bj < 2; ++bj) { f32x4* p = (f32x4*)(rowp + bj * HALF);
          f32x4 a = p[0], b = p[1]; a += acc[ai][bj][m][0] * alpha; b += acc[ai][bj][m][1] * alpha; p[0] = a; p[1] = b; } }
  }
};
struct EpiRet {
  bf16_t* RQ; bf16_t* RK; bf16_t* RKT; bf16_t* RV; bf16_t* RG; const float* ctab; const float* stab; int seqmask;
  __device__ __forceinline__ void operator()(const f32x4 (&acc)[2][2][4][2], const Unit& u, int wr, int wc, int fr, int fq) const {
    const int row0 = u.pm * BM + wr * 64 + fr; const int pn = u.pn; const int cin = wc * 32 + 8 * fq;
    if (pn < 8) {
      const bool isk = pn >= 4; const int head = pn & 3; const float sc = isk ? 0.0625f : 1.f;
      bf16_t* dst = isk ? RK : RQ;
#pragma unroll
      for (int ai = 0; ai < 2; ++ai)
#pragma unroll
        for (int m = 0; m < 4; ++m) { const int lr = row0 + ai * HALF + m * 16; const int pos = lr & seqmask;
          const float* cp = ctab + (size_t)pos * 128 + cin; const float* sp = stab + (size_t)pos * 128 + cin;
          float o1[8], o2[8];
#pragma unroll
          for (int n = 0; n < 2; ++n) { const f32x4 c4 = *(const f32x4*)(cp + 4 * n), s4 = *(const f32x4*)(sp + 4 * n); const f32x4 x1 = acc[ai][0][m][n], x2 = acc[ai][1][m][n];
#pragma unroll
            for (int j = 0; j < 4; ++j) { o1[4 * n + j] = (x1[j] * c4[j] - x2[j] * s4[j]) * sc; o2[4 * n + j] = (x2[j] * c4[j] + x1[j] * s4[j]) * sc; } }
          u32x4 w1, w2; w1.x = cvt_pk_bf16(o1[0], o1[1]); w1.y = cvt_pk_bf16(o1[2], o1[3]); w1.z = cvt_pk_bf16(o1[4], o1[5]); w1.w = cvt_pk_bf16(o1[6], o1[7]);
          w2.x = cvt_pk_bf16(o2[0], o2[1]); w2.y = cvt_pk_bf16(o2[2], o2[3]); w2.z = cvt_pk_bf16(o2[4], o2[5]); w2.w = cvt_pk_bf16(o2[6], o2[7]);
          bf16_t* rp = dst + (size_t)lr * 1024 + head * 256 + cin;
          *(u32x4*)rp = w1; *(u32x4*)(rp + 128) = w2;
          if (isk) { bf16_t* tp = RKT + ((size_t)((lr >> 6) * 4 + head) * 256 + cin) * 64 + (lr & 63);
#pragma unroll
            for (int e = 0; e < 8; ++e) { tp[(size_t)e * 64] = f2bf(o1[e]); tp[(size_t)(e + 128) * 64] = f2bf(o2[e]); } }
        }
    } else {
      const bool isg = pn >= 16; bf16_t* dst = isg ? RG : RV; const int cbase = (isg ? pn - 16 : pn - 8) * 256 + cin;
#pragma unroll
      for (int ai = 0; ai < 2; ++ai)
#pragma unroll
        for (int m = 0; m < 4; ++m) { bf16_t* rowp = dst + (size_t)(row0 + ai * HALF + m * 16) * 2048 + cbase;
#pragma unroll
          for (int bj = 0; bj < 2; ++bj) { f32x4 v0 = acc[ai][bj][m][0], v1 = acc[ai][bj][m][1];
            if (isg) {
#pragma unroll
              for (int j = 0; j < 4; ++j) { v0[j] = silu_f(v0[j]); v1[j] = silu_f(v1[j]); } }
            u32x4 w; w.x = cvt_pk_bf16(v0[0], v0[1]); w.y = cvt_pk_bf16(v0[2], v0[3]); w.z = cvt_pk_bf16(v1[0], v1[1]); w.w = cvt_pk_bf16(v1[2], v1[3]);
            *(u32x4*)(rowp + bj * HALF) = w; } }
    }
  }
};
}

namespace att {
constexpr int KVBLK = 64;
constexpr float SCALE = 0.07216878364870323f;
constexpr float THR = 8.f;
constexpr int SHM_K = KVBLK * 192 * 2, SHM_V = KVBLK * 128 * 2;
#define KSWZ(row, colB) ((row) * 384 + ((colB) ^ (((row) & 7) << 4)))
#define SBAR() __builtin_amdgcn_sched_barrier(0)
__device__ __forceinline__ int crow(int r, int hi) { return (r & 3) + 8 * (r >> 2) + 4 * hi; }
__device__ __forceinline__ void partialSM(f32x16& p0, f32x16& p1, float& m_reg, float& mn, float& alpha) {
  constexpr float C = SCALE * 1.4426950408889634f;
  float pmax = p0[0];
#pragma unroll
  for (int r = 1; r < 16; ++r) pmax = fmaxf(pmax, p0[r]);
#pragma unroll
  for (int r = 0; r < 16; ++r) pmax = fmaxf(pmax, p1[r]);
  { auto rr = __builtin_amdgcn_permlane32_swap(__float_as_uint(pmax), __float_as_uint(pmax), false, false);
    pmax = fmaxf(__uint_as_float(rr[0]), __uint_as_float(rr[1])); }
  if (__builtin_expect(__all(pmax - m_reg <= THR / SCALE), 1)) { mn = m_reg; alpha = 1.f; }
  else { mn = fmaxf(m_reg, pmax); alpha = __builtin_amdgcn_exp2f((m_reg - mn) * C); m_reg = mn; }
  const float mnC = -mn * C;
#pragma unroll
  for (int r = 0; r < 16; ++r) p0[r] = __builtin_amdgcn_exp2f(fmaf(p0[r], C, mnC));
#pragma unroll
  for (int r = 0; r < 16; ++r) p1[r] = __builtin_amdgcn_exp2f(fmaf(p1[r], C, mnC));
}
__device__ __forceinline__ void finishSM(f32x16& p0, f32x16& p1, float alpha, float& l_reg, bf16x8& pa0, bf16x8& pa1, bf16x8& pa2, bf16x8& pa3) {
  float ps = 0;
#pragma unroll
  for (int r = 0; r < 16; ++r) ps += p0[r];
#pragma unroll
  for (int r = 0; r < 16; ++r) ps += p1[r];
  { auto rr = __builtin_amdgcn_permlane32_swap(__float_as_uint(ps), __float_as_uint(ps), false, false);
    ps = __uint_as_float(rr[0]) + __uint_as_float(rr[1]); }
  l_reg = l_reg * alpha + ps;
#define PK4(P, BASE, OUT) do { unsigned a0 = cvt_pk_bf16(P[BASE + 0], P[BASE + 1]), a1 = cvt_pk_bf16(P[BASE + 2], P[BASE + 3]);   \
    unsigned b0 = cvt_pk_bf16(P[BASE + 4], P[BASE + 5]), b1 = cvt_pk_bf16(P[BASE + 6], P[BASE + 7]);                              \
    auto r0 = __builtin_amdgcn_permlane32_swap(a0, b0, false, false); auto r1 = __builtin_amdgcn_permlane32_swap(a1, b1, false, false); \
    u32x4 w = {r0[0], r1[0], r0[1], r1[1]}; OUT = *reinterpret_cast<bf16x8*>(&w); } while (0)
  PK4(p0, 0, pa0); PK4(p0, 8, pa1); PK4(p1, 0, pa2); PK4(p1, 8, pa3);
#undef PK4
}
__device__ __forceinline__ void qkt(f32x16& p0, f32x16& p1, const char* Ks, const bf16x8* qr, int r32, int hi) {
  p0 = f32x16{}; p1 = f32x16{};
#pragma unroll
  for (int d0 = 0; d0 < 12; ++d0) { const int cb = (d0 * 16 + hi * 8) * 2;
    const bf16x8 b0 = *reinterpret_cast<const bf16x8*>(Ks + KSWZ(r32, cb));
    const bf16x8 b1 = *reinterpret_cast<const bf16x8*>(Ks + KSWZ(32 + r32, cb));
    p0 = __builtin_amdgcn_mfma_f32_32x32x16_bf16(b0, qr[d0], p0, 0, 0, 0);
    p1 = __builtin_amdgcn_mfma_f32_32x32x16_bf16(b1, qr[d0], p1, 0, 0, 0); }
}
__device__ __forceinline__ int v_st(int k, int c) { const int kk = (k & ~0xC) | ((k & 4) << 1) | ((k & 8) >> 1); return ((kk >> 3) * 4 + (c >> 5)) * 512 + ((kk & 7) * 32 + (c & 31)) * 2; }
__device__ __forceinline__ int v_rd_base(int lane) { return ((lane & 3) << 3) | (((lane >> 2) & 3) << 6) | (((lane >> 4) & 1) << 5) | (((lane >> 5) & 1) << 8); }
constexpr int v_rd_off(int d0, int ks, int half) { return d0 * 512 + ks * 4096 + half * 2048; }
template <int OFF> __device__ __forceinline__ s16x4 tr_read(int vb) {
  s16x4 r; asm volatile("ds_read_b64_tr_b16 %0, %1 offset:%2" : "=&v"(r) : "v"(vb), "i"(OFF) : "memory"); return r;
}
template <int D0> __device__ __forceinline__ void pv_one(f32x16& od, int vb, bf16x8 pa0, bf16x8 pa1, bf16x8 pa2, bf16x8 pa3) {
  const s16x4 l0 = tr_read<v_rd_off(D0, 0, 0)>(vb), h0 = tr_read<v_rd_off(D0, 0, 1)>(vb), l1 = tr_read<v_rd_off(D0, 1, 0)>(vb), h1 = tr_read<v_rd_off(D0, 1, 1)>(vb);
  const s16x4 l2 = tr_read<v_rd_off(D0, 2, 0)>(vb), h2 = tr_read<v_rd_off(D0, 2, 1)>(vb), l3 = tr_read<v_rd_off(D0, 3, 0)>(vb), h3 = tr_read<v_rd_off(D0, 3, 1)>(vb);
  asm volatile("s_waitcnt lgkmcnt(0)" ::: "memory"); SBAR();
#define PK(L, H) (bf16x8){L[0], L[1], L[2], L[3], H[0], H[1], H[2], H[3]}
  od = __builtin_amdgcn_mfma_f32_32x32x16_bf16(pa0, PK(l0, h0), od, 0, 0, 0);
  od = __builtin_amdgcn_mfma_f32_32x32x16_bf16(pa1, PK(l1, h1), od, 0, 0, 0);
  od = __builtin_amdgcn_mfma_f32_32x32x16_bf16(pa2, PK(l2, h2), od, 0, 0, 0);
  od = __builtin_amdgcn_mfma_f32_32x32x16_bf16(pa3, PK(l3, h3), od, 0, 0, 0);
#undef PK
}
__device__ __forceinline__ void pv_d0(f32x16* o, int vb, bf16x8 pa0, bf16x8 pa1, bf16x8 pa2, bf16x8 pa3) {
  pv_one<0>(o[0], vb, pa0, pa1, pa2, pa3); pv_one<1>(o[1], vb, pa0, pa1, pa2, pa3); pv_one<2>(o[2], vb, pa0, pa1, pa2, pa3); pv_one<3>(o[3], vb, pa0, pa1, pa2, pa3);
}
__device__ __forceinline__ void attn_unit(const bf16_t* __restrict__ Qb, const bf16_t* __restrict__ KVh, const bf16_t* __restrict__ KPEh, bf16_t* __restrict__ Ob, int seq, char* lds, int ldsoff) {
  const int tid = tidx(), wid = tid >> 6, lane = tid & 63, r32 = lane & 31, hi = lane >> 5;
  char* V_lds = lds; char* K_lds = lds + 2 * SHM_V;
  float* ws = (float*)(lds + 2 * SHM_V + 2 * SHM_K) + wid * 64; float* li_l = ws; float* al_l = ws + 32;
  float m_reg = -1e30f, l_reg = 0; f32x16 o[4] = {}; bf16x8 qr[12];
  const bf16_t* Qw = Qb + (long)(wid * 32 + r32) * 1536 + hi * 8;
#pragma unroll
  for (int d0 = 0; d0 < 12; ++d0) qr[d0] = *reinterpret_cast<const bf16x8*>(Qw + d0 * 16);
  const int sr = tid >> 4, sc = (tid & 15) * 8, vst0 = v_st(sr, sc), vst1 = v_st(32 + sr, sc);
  const int pr = tid >> 3, pc = (tid & 7) * 8;
  const int vb0 = ldsoff + v_rd_base(lane);
  bf16x8 vs0, vs1, ks0, ks1, kp;
#define SLOAD(k0) do { vs0 = *reinterpret_cast<const bf16x8*>(&KVh[(long)((k0) + sr) * 2048 + 128 + sc]); vs1 = *reinterpret_cast<const bf16x8*>(&KVh[(long)((k0) + 32 + sr) * 2048 + 128 + sc]); \
    ks0 = *reinterpret_cast<const bf16x8*>(&KVh[(long)((k0) + sr) * 2048 + sc]); ks1 = *reinterpret_cast<const bf16x8*>(&KVh[(long)((k0) + 32 + sr) * 2048 + sc]); \
    kp = *reinterpret_cast<const bf16x8*>(&KPEh[(long)((k0) + pr) * 512 + pc]); } while (0)
#define SWRITE(b) do { *(bf16x8*)(V_lds + (b) * SHM_V + vst0) = vs0; *(bf16x8*)(V_lds + (b) * SHM_V + vst1) = vs1; \
    *(bf16x8*)(K_lds + (b) * SHM_K + KSWZ(sr, sc * 2)) = ks0; *(bf16x8*)(K_lds + (b) * SHM_K + KSWZ(32 + sr, sc * 2)) = ks1; \
    *(bf16x8*)(K_lds + (b) * SHM_K + KSWZ(pr, (128 + pc) * 2)) = kp; } while (0)
  f32x16 p0, p1; float mn, al; bf16x8 pa0, pa1, pa2, pa3; const int NT = seq / KVBLK;
  SLOAD(0); asm volatile("s_waitcnt vmcnt(0)" ::: "memory"); SWRITE(0); __syncthreads();
  for (int j = 0; j < NT; ++j) {
    const int b = j & 1;
    if (j + 1 < NT) SLOAD((j + 1) * KVBLK);
    SBAR();
    qkt(p0, p1, K_lds + b * SHM_K, qr, r32, hi);
    partialSM(p0, p1, m_reg, mn, al);
    if (__any(al < 1.f)) { if (hi == 0) al_l[r32] = al; asm volatile("s_waitcnt lgkmcnt(0)" ::: "memory");
#pragma unroll
      for (int d = 0; d < 4; ++d)
#pragma unroll
        for (int r = 0; r < 16; ++r) o[d][r] *= al_l[crow(r, hi)]; }
    finishSM(p0, p1, al, l_reg, pa0, pa1, pa2, pa3); SBAR();
    pv_d0(o, vb0 + b * SHM_V, pa0, pa1, pa2, pa3);
    if (j + 1 < NT) { asm volatile("s_waitcnt vmcnt(0)" ::: "memory"); SWRITE(b ^ 1); }
    __syncthreads();
  }
  if (hi == 0) li_l[r32] = l_reg; asm volatile("s_waitcnt lgkmcnt(0)" ::: "memory");
  float rli[16];
#pragma unroll
  for (int r = 0; r < 16; ++r) rli[r] = __builtin_amdgcn_rcpf(li_l[crow(r, hi)]);
  bf16_t* Ow = Ob + (long)(wid * 32) * 1024;
#pragma unroll
  for (int r = 0; r < 16; ++r) { const int orow = crow(r, hi);
#pragma unroll
    for (int d0 = 0; d0 < 4; ++d0) Ow[(long)orow * 1024 + d0 * 32 + r32] = f2bf(o[d0][r] * rli[r]); }
  __syncthreads();
#undef SLOAD
#undef SWRITE
}
}

namespace ret {
constexpr int QS = 0, KS = 33792, KTS = 67584, STS = 104448, PS = 121344, VTS = 130560, VZS = 135168;
constexpr int RS = 528, TS = 144;
__device__ __forceinline__ f32x4 mma16(bf16x8 a, bf16x8 b, f32x4 c) { return __builtin_amdgcn_mfma_f32_16x16x32_bf16(a, b, c, 0, 0, 0); }
__device__ __forceinline__ void scan_item(LAS unsigned char* L, const bf16_t* __restrict__ RQ, const bf16_t* __restrict__ RK, const bf16_t* __restrict__ RKT, const bf16_t* __restrict__ RV,
                                          bf16_t* __restrict__ Oo, int seqlen, int s, int hd, int dir, int sl, float lg2) {
  const int tid = tidx(), wid = tid >> 6, lane = tid & 63, l15 = lane & 15, g4 = lane >> 4;
  const int nchunk = seqlen >> 6;
  const int it = wid >> 1, vt = wid & 1, jt0 = 2 * (wid & 1);
  f32x4 st[2][2];
#pragma unroll
  for (int a = 0; a < 2; ++a)
#pragma unroll
    for (int b = 0; b < 2; ++b) st[a][b] = (f32x4){0.f, 0.f, 0.f, 0.f};
  const float gch = __builtin_amdgcn_exp2f(64.f * lg2);
  u32x4 pq[4], pk[4], pt[4], pv;
  const int vrow = tid >> 2, vc4 = tid & 3;
#define RLOAD(c) do { const long tok0 = (long)s * seqlen + (long)(c) * 64; \
    _Pragma("unroll") for (int i = 0; i < 4; ++i) { const int q = tid + 512 * i; const int row = q >> 5, c16 = q & 31; \
      pq[i] = *(const u32x4*)(RQ + (tok0 + row) * 1024 + hd * 256 + c16 * 8); pk[i] = *(const u32x4*)(RK + (tok0 + row) * 1024 + hd * 256 + c16 * 8); \
      pt[i] = *(const u32x4*)(RKT + (((tok0 >> 6) * 4 + hd) * 256) * 64 + (long)q * 8); } \
    if (tid < 256) pv = *(const u32x4*)(RV + (tok0 + vrow) * 2048 + hd * 512 + sl * 32 + vc4 * 8); } while (0)
  RLOAD(dir ? nchunk - 1 : 0);
#ifndef DBG_STEPS
#define DBG_STEPS nchunk
#endif
  for (int cc = 0; cc < DBG_STEPS; ++cc) {
    const int c = dir ? nchunk - 1 - cc : cc;
#pragma unroll
    for (int i = 0; i < 4; ++i) { const int q = tid + 512 * i; const int row = q >> 5, c16 = q & 31;
      *(LAS u32x4*)(L + QS + row * RS + c16 * 16) = pq[i]; *(LAS u32x4*)(L + KS + row * RS + c16 * 16) = pk[i];
      const int dr = q >> 3, c8 = q & 7; *(LAS u32x4*)(L + KTS + dr * TS + c8 * 16) = pt[i]; }
    if (tid < 256) { const float zeta = __builtin_amdgcn_exp2f((dir ? (float)vrow : (float)(63 - vrow)) * lg2);
      const unsigned wv[4] = {pv.x, pv.y, pv.z, pv.w};
#pragma unroll
      for (int e = 0; e < 8; ++e) { const unsigned w = wv[e >> 1]; const unsigned short raw = (e & 1) ? (unsigned short)(w >> 16) : (unsigned short)(w & 0xffffu);
        const int dv = vc4 * 8 + e;
        *(LAS unsigned short*)(L + VTS + dv * TS + vrow * 2) = raw;
        *(LAS unsigned short*)(L + VZS + dv * TS + vrow * 2) = f2bf(bf2f(raw) * zeta); } }
#pragma unroll
    for (int a = 0; a < 2; ++a)
#pragma unroll
      for (int b = 0; b < 2; ++b) { const int d = 16 * (2 * wid + a) + 4 * g4, dv = 16 * b + l15;
        u32x2 w; w.x = cvt_pk_bf16(st[a][b][0], st[a][b][1]); w.y = cvt_pk_bf16(st[a][b][2], st[a][b][3]);
        *(LAS u32x2*)(L + STS + dv * RS + d * 2) = w; }
    __syncthreads();
    if (cc + 1 < nchunk) RLOAD(dir ? nchunk - 2 - cc : cc + 1);
    f32x4 sS0 = {0.f, 0.f, 0.f, 0.f}, sS1 = {0.f, 0.f, 0.f, 0.f}, cX = {0.f, 0.f, 0.f, 0.f};
#pragma unroll
    for (int ks = 0; ks < 8; ++ks) { const int ko = (ks * 32 + 8 * g4) * 2;
      const bf16x8 a = *(const LAS bf16x8*)(L + QS + (16 * it + l15) * RS + ko);
      const bf16x8 b0 = *(const LAS bf16x8*)(L + KS + (16 * jt0 + l15) * RS + ko);
      const bf16x8 b1 = *(const LAS bf16x8*)(L + KS + (16 * (jt0 + 1) + l15) * RS + ko);
      const bf16x8 b2 = *(const LAS bf16x8*)(L + STS + (16 * vt + l15) * RS + ko);
      sS0 = mma16(a, b0, sS0); sS1 = mma16(a, b1, sS1); cX = mma16(a, b2, cX); }
    {
#pragma unroll
      for (int r = 0; r < 4; ++r) { const int i = 16 * it + 4 * g4 + r;
        const int j0 = 16 * jt0 + l15, j1 = j0 + 16;
        const float w0 = dir ? (j0 > i ? __builtin_amdgcn_exp2f((float)(j0 - i) * lg2) : 0.f) : (i >= j0 ? __builtin_amdgcn_exp2f((float)(i - j0) * lg2) : 0.f);
        const float w1 = dir ? (j1 > i ? __builtin_amdgcn_exp2f((float)(j1 - i) * lg2) : 0.f) : (i >= j1 ? __builtin_amdgcn_exp2f((float)(i - j1) * lg2) : 0.f);
        *(LAS unsigned short*)(L + PS + i * TS + j0 * 2) = f2bf(sS0[r] * w0);
        *(LAS unsigned short*)(L + PS + i * TS + j1 * 2) = f2bf(sS1[r] * w1);
        const float xi = __builtin_amdgcn_exp2f((dir ? (float)(64 - i) : (float)(i + 1)) * lg2);
        cX[r] *= xi; }
    }
#pragma unroll
    for (int a = 0; a < 2; ++a)
#pragma unroll
      for (int b = 0; b < 2; ++b) st[a][b] *= gch;
#pragma unroll
    for (int ks = 0; ks < 2; ++ks) { const int ko = (ks * 32 + 8 * g4) * 2;
      const bf16x8 a0 = *(const LAS bf16x8*)(L + KTS + (16 * (2 * wid) + l15) * TS + ko);
      const bf16x8 a1 = *(const LAS bf16x8*)(L + KTS + (16 * (2 * wid + 1) + l15) * TS + ko);
      const bf16x8 b0 = *(const LAS bf16x8*)(L + VZS + (l15) * TS + ko);
      const bf16x8 b1 = *(const LAS bf16x8*)(L + VZS + (16 + l15) * TS + ko);
      st[0][0] = mma16(a0, b0, st[0][0]); st[0][1] = mma16(a0, b1, st[0][1]); st[1][0] = mma16(a1, b0, st[1][0]); st[1][1] = mma16(a1, b1, st[1][1]); }
    __syncthreads();
#pragma unroll
    for (int ks = 0; ks < 2; ++ks) { const int ko = (ks * 32 + 8 * g4) * 2;
      const bf16x8 a = *(const LAS bf16x8*)(L + PS + (16 * it + l15) * TS + ko);
      const bf16x8 b = *(const LAS bf16x8*)(L + VTS + (16 * vt + l15) * TS + ko);
      cX = mma16(a, b, cX); }
    { const long tok0 = (long)s * seqlen + (long)c * 64;
#pragma unroll
      for (int r = 0; r < 4; ++r) { const int i = 16 * it + 4 * g4 + r;
#ifdef DBG_LDSONLY
        const int dvv = 16 * vt + l15;
        float acc_ = bf2f(*(const LAS unsigned short*)(L + QS + i * RS + dvv * 2)) + bf2f(*(const LAS unsigned short*)(L + KS + i * RS + (dvv + 64) * 2))
                   + bf2f(*(const LAS unsigned short*)(L + KTS + (dvv + 32 * (i & 7)) * TS + i * 2)) + bf2f(*(const LAS unsigned short*)(L + VTS + dvv * TS + i * 2))
                   + bf2f(*(const LAS unsigned short*)(L + VZS + dvv * TS + i * 2)) + bf2f(*(const LAS unsigned short*)(L + STS + dvv * RS + (i * 4) * 2));
        cX[r] = acc_;
#endif
        Oo[((long)(hd * 16 + sl) * T_GRP + tok0 + i) * 32 + 16 * vt + l15] = f2bf(cX[r]); } }
    __syncthreads();
  }
#undef RLOAD
}
}

__device__ __forceinline__ void prep_T(float* tile, const float* __restrict__ W, int K, int N, bf16_t* __restrict__ Bt, int mode, int row_off, int& base) {
  const int G = gridDim.x, tid = tidx();
  const int tn = N >> 6, ntile = (K >> 6) * tn;
  int t0 = ((int)blockIdx.x - base % G + G) % G;
  for (int t = t0; t < ntile; t += G) {
    const int k0 = (t / tn) << 6, n0 = (t % tn) << 6;
#pragma unroll
    for (int i = 0; i < 2; ++i) { const int kr = (tid >> 4) + 32 * i, nc = (tid & 15) * 4;
      const f32x4 v = *(const f32x4*)(W + (size_t)(k0 + kr) * N + n0 + nc);
      tile[kr * 65 + nc] = v[0]; tile[kr * 65 + nc + 1] = v[1]; tile[kr * 65 + nc + 2] = v[2]; tile[kr * 65 + nc + 3] = v[3]; }
    __syncthreads();
    { const int n = tid >> 3, kc = (tid & 7) * 8; const int nn = n0 + n;
      const int orow = (mode == 0 ? nn : ((nn >> 2) * 8 + (nn & 3))) + row_off;
      u32x4 w;
      w.x = cvt_pk_bf16(tile[(kc + 0) * 65 + n], tile[(kc + 1) * 65 + n]); w.y = cvt_pk_bf16(tile[(kc + 2) * 65 + n], tile[(kc + 3) * 65 + n]);
      w.z = cvt_pk_bf16(tile[(kc + 4) * 65 + n], tile[(kc + 5) * 65 + n]); w.w = cvt_pk_bf16(tile[(kc + 6) * 65 + n], tile[(kc + 7) * 65 + n]);
      *(u32x4*)(Bt + (size_t)orow * K + k0 + kc) = w; }
    __syncthreads();
  }
  base += ntile;
}
__device__ __forceinline__ void prep_layer(float* tile, const Params& P, int layer) {
  bf16_t* Wb = (bf16_t*)(P.ws + WS_W); int base = 0; const int j = layer >> 1;
#pragma unroll 1
  for (int s = 0; s < 2; ++s) {
    const size_t off = (size_t)(layer * 2 + s) * DM * FF;
    bf16_t* gu = Wb + (s ? WE_GU1 : WE_GU0); bf16_t* dn = Wb + (s ? WE_D1 : WE_D0);
    prep_T(tile, P.ffn_g + off, DM, FF, gu, 1, 0, base);
    prep_T(tile, P.ffn_u + off, DM, FF, gu, 1, 4, base);
    prep_T(tile, P.ffn_d + off, FF, DM, dn, 0, 0, base);
  }
  if ((layer & 1) == 0) {
    prep_T(tile, P.m_dq + (size_t)j * 1024 * 384, 1024, 384, Wb + WE_DQKV, 0, 0, base);
    prep_T(tile, P.m_dkv + (size_t)j * 1024 * 320, 1024, 320, Wb + WE_DQKV, 0, 384, base);
    prep_T(tile, P.m_uq + (size_t)j * 384 * 1536, 384, 1536, Wb + WE_UQ, 0, 0, base);
    prep_T(tile, P.m_ukv + (size_t)j * 256 * 2048, 256, 2048, Wb + WE_UKV, 0, 0, base);
    prep_T(tile, P.m_wo + (size_t)j * 1024 * 1024, 1024, 1024, Wb + WE_MO, 0, 0, base);
    bf16_t* z = Wb + WE_DQKV + (size_t)704 * 1024;
    for (int i = blockIdx.x * 512 + tidx(); i < 64 * 1024 / 8; i += gridDim.x * 512) *(u32x4*)(z + (size_t)i * 8) = (u32x4){0u, 0u, 0u, 0u};
  } else {
    prep_T(tile, P.r_in + (size_t)j * 1024 * 6144, 1024, 6144, Wb + WE_RIN, 0, 0, base);
    prep_T(tile, P.r_wo + (size_t)j * 2048 * 1024, 2048, 1024, Wb + WE_RO, 0, 0, base);
  }
}
__device__ __forceinline__ void build_tables(const Params& P) {
  float* c64 = (float*)(P.ws + WS_TAB); float* s64 = c64 + 8192 * 32; float* c256 = s64 + 8192 * 32; float* s256 = c256 + 8192 * 128;
  const int lane = tidx() & 63, gw = blockIdx.x * 8 + (tidx() >> 6), nw = gridDim.x * 8;
  for (int pos = gw; pos < 8192; pos += nw)
  for (int k = lane; k < 160; k += 64) {
    double rb = (k < 32) ? 0.7498942093324559 : 0.930572040929699; int e = (k < 32) ? k : k - 32; double inv = 1.0;
#pragma unroll 1
    for (; e > 0; e >>= 1) { if (e & 1) inv *= rb; rb *= rb; }
    const double rev = (double)pos * inv * 0.15915494309189535;
    const float f = (float)(rev - rint(rev));
    const float c = __builtin_amdgcn_cosf(f), s = __builtin_amdgcn_sinf(f);
    if (k < 32) { c64[pos * 32 + k] = c; s64[pos * 32 + k] = s; } else { c256[pos * 128 + k - 32] = c; s256[pos * 128 + k - 32] = s; }
  }
}
__device__ __forceinline__ void rows_norm(int mode, const Params& P, const float* __restrict__ g1, const float* __restrict__ g2) {
  float* H = P.out; bf16_t* XN = (bf16_t*)(P.ws + WS_XN);
  const int lane = tidx() & 63, gw = blockIdx.x * 8 + (tidx() >> 6), nw = gridDim.x * 8;
  for (int row = gw; row < T_ALL; row += nw) {
    const float* src = (mode == 0) ? (row < T_GRP ? P.xp + (size_t)row * DM : P.xs + (size_t)(row - T_GRP) * DM) : H + (size_t)row * DM;
    f32x4 v[4]; float ss = 0.f;
#pragma unroll
    for (int i = 0; i < 4; ++i) { v[i] = *(const f32x4*)(src + i * 256 + lane * 4); ss += v[i][0] * v[i][0] + v[i][1] * v[i][1] + v[i][2] * v[i][2] + v[i][3] * v[i][3]; }
    ss = wave_sum(ss); const float rstd = rsqrtf(ss * (1.f / DM) + EPS);
    if (mode == 0) {
#pragma unroll
      for (int i = 0; i < 4; ++i) *(f32x4*)(H + (size_t)row * DM + i * 256 + lane * 4) = v[i]; }
    float ss2 = 0.f;
#pragma unroll
    for (int i = 0; i < 4; ++i) { const f32x4 gg = *(const f32x4*)(g1 + i * 256 + lane * 4); v[i] = v[i] * rstd * gg; ss2 += v[i][0] * v[i][0] + v[i][1] * v[i][1] + v[i][2] * v[i][2] + v[i][3] * v[i][3]; }
    if (mode == 2) {
#pragma unroll
      for (int i = 0; i < 4; ++i) *(f32x4*)(H + (size_t)row * DM + i * 256 + lane * 4) = v[i];
      if (g2 == nullptr) continue;
      ss2 = wave_sum(ss2); const float rstd2 = rsqrtf(ss2 * (1.f / DM) + EPS);
#pragma unroll
      for (int i = 0; i < 4; ++i) { const f32x4 gg = *(const f32x4*)(g2 + i * 256 + lane * 4); v[i] = v[i] * rstd2 * gg; }
    }
#pragma unroll
    for (int i = 0; i < 4; ++i) { u32x2 w; w.x = cvt_pk_bf16(v[i][0], v[i][1]); w.y = cvt_pk_bf16(v[i][2], v[i][3]); *(u32x2*)(XN + (size_t)row * DM + i * 256 + lane * 4) = w; }
  }
}
__device__ __forceinline__ void rows_mla_a(const Params& P, int j) {
  bf16_t* C = (bf16_t*)(P.ws + WS_S + S_CQKV); const float* qa = P.m_qa + j * 384; const float* kva = P.m_kva + j * 256;
  const int lane = tidx() & 63, gw = blockIdx.x * 8 + (tidx() >> 6), nw = gridDim.x * 8;
  for (int row = gw; row < T_ALL; row += nw) {
    bf16_t* r = C + (size_t)row * 768;
    unsigned q[3]; float ssq = 0.f;
#pragma unroll
    for (int i = 0; i < 3; ++i) { q[i] = *(const unsigned*)(r + i * 128 + lane * 2); const float a = bflo(q[i]), b = bfhi(q[i]); ssq += a * a + b * b; }
    const u32x2 kk = *(const u32x2*)(r + 384 + lane * 4);
    float kv[4] = {bflo(kk.x), bfhi(kk.x), bflo(kk.y), bfhi(kk.y)};
    float ssk = kv[0] * kv[0] + kv[1] * kv[1] + kv[2] * kv[2] + kv[3] * kv[3];
    ssq = wave_sum(ssq); ssk = wave_sum(ssk);
    const float rq = rsqrtf(ssq * (1.f / 384.f) + EPS), rk = rsqrtf(ssk * (1.f / 256.f) + EPS);
#pragma unroll
    for (int i = 0; i < 3; ++i) { const int c = i * 128 + lane * 2; *(unsigned*)(r + c) = cvt_pk_bf16(bflo(q[i]) * rq * qa[c], bfhi(q[i]) * rq * qa[c + 1]); }
    { const int c = lane * 4; u32x2 w; w.x = cvt_pk_bf16(kv[0] * rk * kva[c], kv[1] * rk * kva[c + 1]); w.y = cvt_pk_bf16(kv[2] * rk * kva[c + 2], kv[3] * rk * kva[c + 3]); *(u32x2*)(r + 384 + c) = w; }
  }
}
__device__ __forceinline__ void rows_mla_b(const Params& P, int j, int grp) {
  bf16_t* Qg = (bf16_t*)(P.ws + WS_S + S_Q); bf16_t* KVg = (bf16_t*)(P.ws + WS_S + S_KV); bf16_t* KPE = (bf16_t*)(P.ws + WS_S + S_KPE);
  const bf16_t* C = (const bf16_t*)(P.ws + WS_S + S_CQKV);
  const float* qn = P.m_qn + j * 192; const float* kn = P.m_kn + j * 192;
  const float* c64 = (const float*)(P.ws + WS_TAB); const float* s64 = c64 + 8192 * 32;
  const int lane = tidx() & 63, gw = blockIdx.x * 8 + (tidx() >> 6), nw = gridDim.x * 8;
  const int hd = lane >> 3, sub = lane & 7; const int seqmask = grp == 0 ? 4095 : 8191;
  for (int t = gw; t < T_GRP; t += nw) {
    const int pos = t & seqmask; const size_t grow = (size_t)grp * T_GRP + t;
    const float* cp = c64 + pos * 32 + (sub & 3) * 8; const float* sp = s64 + pos * 32 + (sub & 3) * 8;
    float cs[8], sn[8];
#pragma unroll
    for (int e = 0; e < 8; ++e) { cs[e] = cp[e]; sn[e] = sp[e]; }
    { bf16_t* qp = Qg + (size_t)t * 1536 + hd * 192 + sub * 8;
      float x[24]; float ss = 0.f;
#pragma unroll
      for (int c = 0; c < 3; ++c) { const u32x4 w = *(const u32x4*)(qp + 64 * c); const unsigned ww[4] = {w.x, w.y, w.z, w.w};
#pragma unroll
        for (int e = 0; e < 4; ++e) { x[c * 8 + 2 * e] = bflo(ww[e]); x[c * 8 + 2 * e + 1] = bfhi(ww[e]); } }
#pragma unroll
      for (int e = 0; e < 24; ++e) ss += x[e] * x[e];
      ss += __shfl_xor(ss, 1); ss += __shfl_xor(ss, 2); ss += __shfl_xor(ss, 4);
      const float rstd = rsqrtf(ss * (1.f / 192.f) + EPS);
#pragma unroll
      for (int c = 0; c < 3; ++c)
#pragma unroll
        for (int e = 0; e < 8; ++e) x[c * 8 + e] *= rstd * qn[c * 64 + sub * 8 + e];
#pragma unroll
      for (int e = 0; e < 8; ++e) { const float own = x[16 + e]; const float oth = __shfl_xor(own, 4);
        x[16 + e] = (sub < 4) ? (own * cs[e] - oth * sn[e]) : (own * cs[e] + oth * sn[e]); }
#pragma unroll
      for (int c = 0; c < 3; ++c) { u32x4 w; w.x = cvt_pk_bf16(x[c * 8], x[c * 8 + 1]); w.y = cvt_pk_bf16(x[c * 8 + 2], x[c * 8 + 3]); w.z = cvt_pk_bf16(x[c * 8 + 4], x[c * 8 + 5]); w.w = cvt_pk_bf16(x[c * 8 + 6], x[c * 8 + 7]);
        *(u32x4*)(qp + 64 * c) = w; }
    }
    { bf16_t* kp = KVg + (size_t)t * 2048 + hd * 256 + sub * 8; const bf16_t* pp = C + grow * 768 + 640 + sub * 8;
      float x[24]; float ss = 0.f;
#pragma unroll
      for (int c = 0; c < 3; ++c) { const u32x4 w = (c < 2) ? *(const u32x4*)(kp + 64 * c) : *(const u32x4*)pp; const unsigned ww[4] = {w.x, w.y, w.z, w.w};
#pragma unroll
        for (int e = 0; e < 4; ++e) { x[c * 8 + 2 * e] = bflo(ww[e]); x[c * 8 + 2 * e + 1] = bfhi(ww[e]); } }
#pragma unroll
      for (int e = 0; e < 24; ++e) ss += x[e] * x[e];
      ss += __shfl_xor(ss, 1); ss += __shfl_xor(ss, 2); ss += __shfl_xor(ss, 4);
      const float rstd = rsqrtf(ss * (1.f / 192.f) + EPS);
#pragma unroll
      for (int c = 0; c < 3; ++c)
#pragma unroll
        for (int e = 0; e < 8; ++e) x[c * 8 + e] *= rstd * kn[c * 64 + sub * 8 + e];
#pragma unroll
      for (int e = 0; e < 8; ++e) { const float own = x[16 + e]; const float oth = __shfl_xor(own, 4);
        x[16 + e] = (sub < 4) ? (own * cs[e] - oth * sn[e]) : (own * cs[e] + oth * sn[e]); }
#pragma unroll
      for (int c = 0; c < 2; ++c) { u32x4 w; w.x = cvt_pk_bf16(x[c * 8], x[c * 8 + 1]); w.y = cvt_pk_bf16(x[c * 8 + 2], x[c * 8 + 3]); w.z = cvt_pk_bf16(x[c * 8 + 4], x[c * 8 + 5]); w.w = cvt_pk_bf16(x[c * 8 + 6], x[c * 8 + 7]);
        *(u32x4*)(kp + 64 * c) = w; }
      { u32x4 w; w.x = cvt_pk_bf16(x[16], x[17]); w.y = cvt_pk_bf16(x[18], x[19]); w.z = cvt_pk_bf16(x[20], x[21]); w.w = cvt_pk_bf16(x[22], x[23]);
        *(u32x4*)(KPE + (size_t)t * 512 + hd * 64 + sub * 8) = w; }
    }
  }
}
__device__ __forceinline__ void rows_ret_gn(const Params& P, int j) {
  bf16_t* Y = (bf16_t*)(P.ws + WS_S + S_RQ); const bf16_t* OF = (const bf16_t*)(P.ws + WS_S + S_OF); const bf16_t* OB = (const bf16_t*)(P.ws + WS_S + S_OB); const bf16_t* RG = (const bf16_t*)(P.ws + WS_S + S_RG);
  const float* gn = P.r_gn + j * 2048;
  const int lane = tidx() & 63, gw = blockIdx.x * 8 + (tidx() >> 6), nw = gridDim.x * 8;
  for (int task = gw; task < T_GRP * 4; task += nw) {
    const size_t off = (size_t)(task >> 2) * 2048 + (task & 3) * 512 + lane * 8;
    const size_t offo = ((size_t)((task & 3) * 16 + (lane >> 2)) * T_GRP + (task >> 2)) * 32 + (lane & 3) * 8;
    const u32x4 a = *(const u32x4*)(OF + offo), b = *(const u32x4*)(OB + offo), g = *(const u32x4*)(RG + off);
    const unsigned aw[4] = {a.x, a.y, a.z, a.w}, bw[4] = {b.x, b.y, b.z, b.w}, gw4[4] = {g.x, g.y, g.z, g.w};
    float o[8]; float sm = 0.f;
#pragma unroll
    for (int e = 0; e < 4; ++e) { o[2 * e] = bflo(aw[e]) + bflo(bw[e]); o[2 * e + 1] = bfhi(aw[e]) + bfhi(bw[e]); sm += o[2 * e] + o[2 * e + 1]; }
    sm = wave_sum(sm); const float mu = sm * (1.f / 512.f);
    float vs = 0.f;
#pragma unroll
    for (int e = 0; e < 8; ++e) { o[e] -= mu; vs += o[e] * o[e]; }
    vs = wave_sum(vs); const float rstd = rsqrtf(vs * (1.f / 512.f) + EPS);
    const float* gp = gn + (task & 3) * 512 + lane * 8;
    float y[8];
#pragma unroll
    for (int e = 0; e < 4; ++e) { y[2 * e] = o[2 * e] * rstd * gp[2 * e] * bflo(gw4[e]); y[2 * e + 1] = o[2 * e + 1] * rstd * gp[2 * e + 1] * bfhi(gw4[e]); }
    u32x4 w; w.x = cvt_pk_bf16(y[0], y[1]); w.y = cvt_pk_bf16(y[2], y[3]); w.z = cvt_pk_bf16(y[4], y[5]); w.w = cvt_pk_bf16(y[6], y[7]);
    *(u32x4*)(Y + off) = w;
  }
}


#define XB_TMO      128
#define XB_XCNT(j)  (256  + 64 * (j))
#define XB_XSUB(j)  (1280 + 64 * (j))
#define XB_XGEN(j)  (2304 + 64 * (j))
#define XB_TOP      3328
#define XB_TOPGEN   3392
#define XCD_BAR_WORDS 3456
#define XB_SPIN_CAP (1u << 22)
__device__ __forceinline__ unsigned xb_ld(unsigned* p)              { return __hip_atomic_load(p, __ATOMIC_RELAXED, __HIP_MEMORY_SCOPE_AGENT); }
__device__ __forceinline__ unsigned xb_add(unsigned* p, unsigned v) { return __hip_atomic_fetch_add(p, v, __ATOMIC_RELAXED, __HIP_MEMORY_SCOPE_AGENT); }
__device__ __forceinline__ unsigned xb_xcc_id() { return (unsigned)__builtin_amdgcn_s_getreg((3 << 11) | 20) & 0xFu; }
#define XB_SPIN(cond, bar) do { unsigned _sp = 0; while (cond) { __builtin_amdgcn_s_sleep(1); \
    if ((++_sp & 255u) == 0u) { if (xb_ld(&(bar)[XB_TMO])) break; if (_sp > XB_SPIN_CAP) { atomicAdd(&(bar)[XB_TMO], 1u); break; } } } } while (0)
__device__ __forceinline__ void xcd_barrier_complete(unsigned* bar, unsigned x, unsigned& nloc, unsigned& nx) {
    const unsigned G = gridDim.x;
    unsigned sum, cnt, mine, sp = 0u;
    for (;;) {
        sum = 0u; cnt = 0u; mine = 0u;
#pragma unroll
        for (unsigned j = 0; j < 16; ++j) { const unsigned c = xb_ld(&bar[XB_XCNT(j)]); sum += c; cnt += (c > 0u) ? 1u : 0u; mine = (j == x) ? c : mine; }
        if (sum == G) break;
        __builtin_amdgcn_s_sleep(1);
        if ((++sp & 255u) == 0u) { if (xb_ld(&bar[XB_TMO])) break; if (sp > XB_SPIN_CAP) { atomicAdd(&bar[XB_TMO], 1u); break; } }
    }
    nloc = mine > 0u ? mine : 1u; nx = cnt > 0u ? cnt : 1u;
}
__device__ __forceinline__ void xcd_barrier(unsigned* bar, unsigned x, volatile LAS unsigned* st) {
    asm volatile("s_waitcnt vmcnt(0)" ::: "memory");
    __syncthreads();
    if (threadIdx.x == 0) {
        __builtin_amdgcn_s_waitcnt(0);
        unsigned nloc = st[0], nx = st[1];
        if (nloc == 0u) { xcd_barrier_complete(bar, x, nloc, nx); st[0] = nloc; st[1] = nx; }
        const unsigned old = xb_add(&bar[XB_XSUB(x)], 1u);
        const unsigned gen = old / nloc;
        if (old + 1u == (gen + 1u) * nloc) {
            __builtin_amdgcn_fence(__ATOMIC_RELEASE, "agent");
            asm volatile("s_waitcnt vmcnt(0)" ::: "memory");
            const unsigned og = xb_add(&bar[XB_TOP], 1u);
            const unsigned tg = og / nx;
            if (og + 1u == (tg + 1u) * nx) xb_add(&bar[XB_TOPGEN], 1u);
            else XB_SPIN(xb_ld(&bar[XB_TOPGEN]) == tg, bar);
            __builtin_amdgcn_fence(__ATOMIC_ACQUIRE, "agent");
            xb_add(&bar[XB_XGEN(x)], 1u);
            asm volatile("s_waitcnt vmcnt(0)" ::: "memory");
        } else {
            XB_SPIN(xb_ld(&bar[XB_XGEN(x)]) == gen, bar);
            __builtin_amdgcn_fence(__ATOMIC_ACQUIRE, "agent");
            asm volatile("s_waitcnt vmcnt(0)" ::: "memory");
        }
    }
    __syncthreads();
}
#define GRID_BARRIER(wsptr) xcd_barrier((unsigned*)((wsptr) + WS_BAR), xcc_id, (volatile LAS unsigned*)(L + LDS_BYTES - 64))
constexpr int PH_PER_LAYER = 19, N_PHASES = 1 + 4 * PH_PER_LAYER;
__global__ void __launch_bounds__(512, 2) mega(Params Pk) {
  extern __shared__ __attribute__((aligned(16))) unsigned char lds_raw[];
  cg::grid_group grid = cg::this_grid();
  LAS unsigned char* L = (LAS unsigned char*)lds_raw;
  const int G = gridDim.x;
  const int ph_lo = Pk.ph_lo, ph_hi = Pk.ph_hi;
  if (ph_lo < 0) grid.sync();
  const unsigned xcc_id = xb_xcc_id();
  if (threadIdx.x < 16) ((volatile LAS unsigned*)(L + LDS_BYTES - 64))[threadIdx.x] = 0u;
  if (threadIdx.x == 0) (void)xb_add(&((unsigned*)(Pk.ws + WS_BAR))[XB_XCNT(xcc_id)], 1u);
  __syncthreads();
#pragma unroll 1
  for (int ph = ph_lo; ph < ph_hi; ++ph) {
#if defined(__HIP_DEVICE_COMPILE__)
    const __attribute__((address_space(4))) Params* pp = (const __attribute__((address_space(4))) Params*)__builtin_amdgcn_kernarg_segment_ptr();
    asm volatile("" : "+s"(pp));
    const Params P = *pp;
#else
    const Params P = Pk;
#endif
    bf16_t* Wb = (bf16_t*)(P.ws + WS_W); bf16_t* XN = (bf16_t*)(P.ws + WS_XN); unsigned char* SB = P.ws + WS_S;
    float* H = P.out;
    if (ph == 0) {
      prep_layer((float*)lds_raw, P, 0); build_tables(P); rows_norm(0, P, P.norm_g, nullptr);
    } else {
      const int layer = (ph - 1) / PH_PER_LAYER, p = (ph - 1) % PH_PER_LAYER, j = layer >> 1; const bool is_ret = layer & 1;
      const float* ng = P.norm_g + layer * 4 * DM;
      int op = 0, grp = 0, s = 0;
      if (p == 0 || p == 16) { op = 0; s = (p == 16); }
      else if (p == 1 || p == 17) { op = 1; s = (p == 17); }
      else if (p == 2 || p == 15) op = 2;
      else if (p == 18) op = 3;
      else if (!is_ret) {
        if (p == 3) op = 4; else if (p == 4) op = 5; else if (p == 14) op = 1;
        else { grp = (p - 5) / 3; const int sub = (p - 5) % 3; op = sub == 0 ? 4 : (sub == 1 ? 6 : 7); }
      } else { grp = (p - 3) / 4; const int sub = (p - 3) % 4; op = sub == 0 ? 8 : (sub == 1 ? 9 : (sub == 2 ? 10 : 1)); }
      const int seqlen = grp == 0 ? 4096 : 8192, nseq = grp == 0 ? 4 : 2;

      if (op == 0) {
        pg8::Gemm g{XN, Wb + (s ? WE_GU1 : WE_GU0), T_ALL, 2 * FF, DM, DM}; pg8::StaticOrder S; S.init(T_ALL, 2 * FF, G, blockIdx.x);
        pg8::EpiSwiGLU E{(bf16_t*)(SB + S_ACT)};
#ifndef REP_FFNUP
#define REP_FFNUP 1
#endif
#pragma unroll 1
        for (int rep = 0; rep < REP_FFNUP; ++rep) pg8::gemm_phase(L, g, S, E);
      } else if (op == 1) {
        pg8::Gemm g; float* Hh = H; float alpha = 0.5f;
        if (p == 1 || p == 17) g = pg8::Gemm{(const bf16_t*)(SB + S_ACT), Wb + (s ? WE_D1 : WE_D0), T_ALL, DM, FF, FF};
        else if (!is_ret) { g = pg8::Gemm{XN, Wb + WE_MO, T_ALL, DM, DM, DM}; alpha = 1.f; }
        else { g = pg8::Gemm{(const bf16_t*)(SB + S_RQ), Wb + WE_RO, T_GRP, DM, 2048, 2048}; alpha = 1.f; Hh = H + (size_t)grp * T_GRP * DM; }
        pg8::StaticOrder S; S.init(g.M, DM, G, blockIdx.x);
        pg8::EpiResid E{Hh, alpha}; pg8::gemm_phase(L, g, S, E);
      } else if (op == 2) {
#ifndef REP_NORM
#define REP_NORM 1
#endif
        for (int rn_ = 0; rn_ < REP_NORM; ++rn_) rows_norm(1, P, ng + (p == 2 ? 1 : 2) * DM, nullptr);
      } else if (op == 3) {
        if (layer < 3) prep_layer((float*)lds_raw, P, layer + 1);
        rows_norm(2, P, ng + 3 * DM, layer < 3 ? ng + 4 * DM : nullptr);
      } else if (op == 4) {
        const int ng2 = (p == 3) ? 1 : 2;
#pragma unroll 1
        for (int gi = 0; gi < ng2; ++gi) {
          pg8::Gemm g; pg8::EpiBf16 E;
          if (p == 3) { g = pg8::Gemm{XN, Wb + WE_DQKV, T_ALL, 768, DM, DM}; E = pg8::EpiBf16{(bf16_t*)(SB + S_CQKV), 768}; }
          else if (gi == 0) { g = pg8::Gemm{(const bf16_t*)(SB + S_CQKV) + (size_t)grp * T_GRP * 768, Wb + WE_UQ, T_GRP, 1536, 384, 768}; E = pg8::EpiBf16{(bf16_t*)(SB + S_Q), 1536}; }
          else { g = pg8::Gemm{(const bf16_t*)(SB + S_CQKV) + (size_t)grp * T_GRP * 768 + 384, Wb + WE_UKV, T_GRP, 2048, 256, 768}; E = pg8::EpiBf16{(bf16_t*)(SB + S_KV), 2048}; }
          pg8::StaticOrder S; S.init(g.M, g.N, G, blockIdx.x);
          pg8::gemm_phase(L, g, S, E);
        }
      } else if (op == 5) {
        rows_mla_a(P, j);
      } else if (op == 6) {
        rows_mla_b(P, j, grp);
      } else if (op == 7) {
        const int nqb = seqlen >> 8; const int nunits = nseq * 8 * nqb;
        const bf16_t* Qg = (const bf16_t*)(SB + S_Q); const bf16_t* KVg = (const bf16_t*)(SB + S_KV); const bf16_t* KPE = (const bf16_t*)(SB + S_KPE);
#ifndef REP_ATTN
#define REP_ATTN 1
#endif
#pragma unroll 1
        for (int rep = 0; rep < REP_ATTN; ++rep)
#pragma unroll 1
        for (int u = blockIdx.x; u < nunits; u += G) {
          const int qb = u % nqb, hd = (u / nqb) & 7, sq = u / (nqb * 8);
          const size_t r0 = (size_t)sq * seqlen;
          att::attn_unit(Qg + (r0 + (size_t)qb * 256) * 1536 + hd * 192, KVg + r0 * 2048 + hd * 256, KPE + r0 * 512 + hd * 64,
                         XN + ((size_t)grp * T_GRP + r0 + (size_t)qb * 256) * DM + hd * 128, seqlen, (char*)lds_raw, (int)(uintptr_t)L);
        }
      } else if (op == 8) {
        const float* c256 = (const float*)(P.ws + WS_TAB) + 2 * 8192 * 32;
        pg8::Gemm g{XN + (size_t)grp * T_GRP * DM, Wb + WE_RIN, T_GRP, 6144, DM, DM}; pg8::StaticOrder S; S.init(T_GRP, 6144, G, blockIdx.x);
        pg8::EpiRet E{(bf16_t*)(SB + S_RQ), (bf16_t*)(SB + S_RK), (bf16_t*)(SB + S_RKT), (bf16_t*)(SB + S_RV), (bf16_t*)(SB + S_RG), c256, c256 + 8192 * 128, seqlen - 1};
        pg8::gemm_phase(L, g, S, E);
      } else if (op == 9) {
        const int nitems = nseq * 4 * 2 * 16;
#ifndef REP_SCAN
#define REP_SCAN 1
#endif
#pragma unroll 1
        for (int rep = 0; rep < REP_SCAN; ++rep)
#pragma unroll 1
        for (int itx = blockIdx.x; itx < nitems; itx += G) {
          const int sl = itx & 15, dir = (itx >> 4) & 1, hd = (itx >> 5) & 3, sq = itx >> 7;
          const float dec = (dir ? P.r_db : P.r_df)[j * 4 + hd];
          const float xg = __builtin_amdgcn_exp2f(dec * 1.4426950408889634f);
          const float ser = xg * (1.f + xg * (0.5f + xg * (0.33333334f + xg * (0.25f + xg * (0.2f + xg * (0.16666667f + xg * (0.14285715f + xg * 0.125f)))))));
          const float lg2 = -ser * 1.4426950408889634f;
          ret::scan_item(L, (const bf16_t*)(SB + S_RQ), (const bf16_t*)(SB + S_RK), (const bf16_t*)(SB + S_RKT), (const bf16_t*)(SB + S_RV),
                         (bf16_t*)(SB + (dir ? S_OB : S_OF)), seqlen, sq, hd, dir, sl, lg2);
        }
      } else if (op == 10) {
        rows_ret_gn(P, j);
      }
    }
#ifndef REP_BAR
#define REP_BAR 1
#endif
    if (ph + 1 < ph_hi) { for (int rb_ = 0; rb_ < REP_BAR; ++rb_) GRID_BARRIER(P.ws); }
  }
#ifdef DBG_N
  {
    unsigned char* wsb = Pk.ws; float* Hh = Pk.out; const unsigned* XNw = (const unsigned*)(wsb + WS_XN);
    GRID_BARRIER(wsb);
    unsigned hsh = 0, nanc = 0; const size_t nth = (size_t)G * 512, gt = (size_t)blockIdx.x * 512 + threadIdx.x;
#if DBG_WHAT & 1
    for (size_t i = gt; i < (size_t)T_ALL * DM; i += nth) { const unsigned u = __float_as_uint(Hh[i]); hsh += u * 2654435761u + 1u; if ((u & 0x7f800000u) == 0x7f800000u) ++nanc; }
#endif
#if DBG_WHAT & 2
    for (size_t i = gt; i < (size_t)T_ALL * DM / 2; i += nth) { const unsigned u = XNw[i]; hsh += u * 2246822519u + 1u; if ((u & 0x7f800000u) == 0x7f800000u || (u & 0x7f80u) == 0x7f80u) ++nanc; }
#endif
#if DBG_WHAT & 4
    { const unsigned* Sw = (const unsigned*)(wsb + WS_S + DBG_OFF); for (size_t i = gt; i < (size_t)DBG_LEN / 4; i += nth) { const unsigned u = Sw[i]; hsh += u * 3266489917u + 1u; if ((u & 0x7f800000u) == 0x7f800000u || (u & 0x7f80u) == 0x7f80u) ++nanc; } }
#endif
    unsigned* cnt = (unsigned*)(wsb + WS_BAR) + 3520;
    atomicAdd(cnt, hsh); atomicAdd(cnt + 1, nanc);
    GRID_BARRIER(wsb);
    const unsigned th = __hip_atomic_load(cnt, __ATOMIC_RELAXED, __HIP_MEMORY_SCOPE_AGENT), tn = __hip_atomic_load(cnt + 1, __ATOMIC_RELAXED, __HIP_MEMORY_SCOPE_AGENT);
    const float v = (tn ? 30.f : 10.f) + (float)(th & 1023u) * 1e-3f;
    for (size_t i = gt; i < (size_t)T_ALL * DM; i += nth) Hh[i] = v;
  }
#endif
}

extern "C" void kernel_launch(void* const* d_in, const int* in_sizes, int n_in, void* d_out, int out_size, void* d_ws, size_t ws_size, hipStream_t stream) {
  static int grid_blocks = 0;
  if (grid_blocks == 0) {
    if (n_in != 20 || out_size != T_ALL * DM || ws_size < WS_END) { fprintf(stderr, "kernel_launch: unexpected shapes n_in %d out %d ws %zu (need %zu)\n", n_in, out_size, ws_size, (size_t)WS_END); }
    int dev = 0, cus = 0, per_cu = 0;
    (void)hipGetDevice(&dev);
    (void)hipDeviceGetAttribute(&cus, hipDeviceAttributeMultiprocessorCount, dev);
    if (hipFuncSetAttribute((const void*)mega, hipFuncAttributeMaxDynamicSharedMemorySize, LDS_BYTES) != hipSuccess) fprintf(stderr, "kernel_launch: hipFuncSetAttribute failed\n");
    if (hipOccupancyMaxActiveBlocksPerMultiprocessor(&per_cu, (const void*)mega, 512, LDS_BYTES) != hipSuccess || per_cu < 1) { fprintf(stderr, "kernel_launch: occupancy query gave %d\n", per_cu); per_cu = 1; }
    (void)hipGetLastError();
    grid_blocks = cus * per_cu;
  }
  Params p{};
  p.xp = (const float*)d_in[0]; p.xs = (const float*)d_in[1]; p.norm_g = (const float*)d_in[2]; p.ffn_g = (const float*)d_in[3]; p.ffn_u = (const float*)d_in[4]; p.ffn_d = (const float*)d_in[5];
  p.m_dq = (const float*)d_in[6]; p.m_qa = (const float*)d_in[7]; p.m_uq = (const float*)d_in[8]; p.m_dkv = (const float*)d_in[9]; p.m_kva = (const float*)d_in[10]; p.m_ukv = (const float*)d_in[11];
  p.m_qn = (const float*)d_in[12]; p.m_kn = (const float*)d_in[13]; p.m_wo = (const float*)d_in[14];
  p.r_in = (const float*)d_in[15]; p.r_df = (const float*)d_in[16]; p.r_db = (const float*)d_in[17]; p.r_gn = (const float*)d_in[18]; p.r_wo = (const float*)d_in[19];
  p.out = (float*)d_out; p.ws = (unsigned char*)d_ws; p.ph_lo = 0; p.ph_hi = N_PHASES;
#ifdef DBG_N
  p.ph_hi = DBG_N;
#endif
  (void)hipMemsetAsync((char*)d_ws + WS_BAR, 0, 16384, stream);
  void* args[] = {&p};
  hipError_t e = hipLaunchCooperativeKernel((const void*)mega, dim3(grid_blocks), dim3(512), args, LDS_BYTES, stream);
  if (e != hipSuccess) fprintf(stderr, "kernel_launch: cooperative launch failed: %s (grid %d)\n", hipGetErrorString(e), grid_blocks);
}
```

```cpp
#include <hip/hip_runtime.h>
#include <hip/hip_cooperative_groups.h>
#include <cstdio>
#include <cstdint>
#include <cmath>
namespace cg = cooperative_groups;

#define LAS __attribute__((address_space(3)))
typedef unsigned short bf16_t;
typedef short bf16x8 __attribute__((ext_vector_type(8)));
typedef short s16x4 __attribute__((ext_vector_type(4)));
typedef float f32x4 __attribute__((ext_vector_type(4)));
typedef float f32x16 __attribute__((ext_vector_type(16)));
typedef unsigned u32x4 __attribute__((ext_vector_type(4)));
typedef unsigned u32x2 __attribute__((ext_vector_type(2)));

constexpr int T_ALL = 49152, T_GRP = 16384, DM = 1024, FF = 2816;
constexpr float EPS = 1e-6f;
constexpr int LDS_BYTES = 147456;
constexpr size_t MiB = 1u << 20;
constexpr size_t WS_W = 0;
constexpr size_t WS_TAB = 56 * MiB;
constexpr size_t WS_XN = 66 * MiB;
constexpr size_t WS_S = 162 * MiB;
constexpr size_t WS_BAR = WS_S + 352 * MiB;
constexpr size_t WS_P = WS_BAR + 16384;
constexpr size_t WS_END = WS_P + 16 * MiB;
constexpr size_t WE_GU0 = 0, WE_D0 = WE_GU0 + (size_t)5632 * 1024, WE_GU1 = WE_D0 + (size_t)1024 * 2816, WE_D1 = WE_GU1 + (size_t)5632 * 1024,
                 WE_MIX = WE_D1 + (size_t)1024 * 2816;
constexpr size_t WE_DQKV = WE_MIX, WE_UQ = WE_DQKV + (size_t)768 * 1024, WE_UKV = WE_UQ + (size_t)1536 * 384, WE_MO = WE_UKV + (size_t)2048 * 256;
constexpr size_t WE_RIN = WE_MIX, WE_RO = WE_RIN + (size_t)6144 * 1024;
constexpr size_t S_ACT = 0;
constexpr size_t S_CQKV = 0, S_Q = 72 * MiB, S_KV = 120 * MiB, S_KPE = 184 * MiB;
constexpr size_t S_RQ = 0, S_RK = 32 * MiB, S_RKT = 64 * MiB, S_RV = 96 * MiB, S_RG = 160 * MiB, S_OF = 224 * MiB, S_OB = 288 * MiB;

struct Params {
  const float* xp; const float* xs; const float* norm_g; const float* ffn_g; const float* ffn_u; const float* ffn_d;
  const float* m_dq; const float* m_qa; const float* m_uq; const float* m_dkv; const float* m_kva; const float* m_ukv;
  const float* m_qn; const float* m_kn; const float* m_wo;
  const float* r_in; const float* r_df; const float* r_db; const float* r_gn; const float* r_wo;
  float* out; unsigned char* ws;
  int ph_lo, ph_hi;
};

typedef __bf16 bf16x2_t __attribute__((ext_vector_type(2)));
typedef float f32x2_t __attribute__((ext_vector_type(2)));
__device__ __forceinline__ unsigned cvt_pk_bf16(float lo, float hi) { const f32x2_t v = {lo, hi}; const bf16x2_t b = __builtin_convertvector(v, bf16x2_t); return __builtin_bit_cast(unsigned, b); }
__device__ __forceinline__ float bflo(unsigned w) { return __uint_as_float(w << 16); }
__device__ __forceinline__ float bfhi(unsigned w) { return __uint_as_float(w & 0xffff0000u); }
__device__ __forceinline__ float bf2f(unsigned short u) { return __uint_as_float(((unsigned)u) << 16); }
__device__ __forceinline__ unsigned short f2bf(float f) { return (unsigned short)(cvt_pk_bf16(f, 0.f) & 0xffffu); }
__device__ __forceinline__ float wave_sum(float v) {
#pragma unroll
  for (int o = 32; o > 0; o >>= 1) v += __shfl_xor(v, o);
  return v;
}
__device__ __forceinline__ int tidx() { int t = threadIdx.x; asm volatile("" : "+v"(t)); return t; }
__device__ __forceinline__ float silu_f(float x) { return x * __builtin_amdgcn_rcpf(1.f + __builtin_amdgcn_exp2f(-1.4426950408889634f * x)); }

namespace pg8 {
constexpr int BM = 256, BK = 64, HALF = 128, HTB = HALF * BK * 2, NXCD = 8, WGM = 8;
__host__ __device__ __forceinline__ int lds_byte(int r, int c) { const int st = (r >> 4) * 2 + (c >> 5), rr = r & 15, cc = c & 31, ob = rr * 64 + cc * 2; return st * 1024 + (ob ^ (((ob >> 9) & 1) << 5)); }
__host__ __device__ __forceinline__ void stage_rc(int b, int& R, int& C) { const int st = b / 1024, sb = b % 1024, swz = sb ^ (((sb >> 9) & 1) << 5); R = (st >> 1) * 16 + swz / 64; C = (st & 1) * 32 + (swz % 64) / 2; }
__host__ __device__ __forceinline__ int perm32(int rho) { const int n = rho >> 4, i = rho & 15; return 8 * (i >> 2) + 4 * n + (i & 3); }
struct Unit { int pm, pn; };
struct Gemm { const bf16_t* A; const bf16_t* Bt; int M, N, K, lda; };
struct StaticOrder {
  int nM, nN, nwg, G, c;
  __device__ void init(int M, int N, int G_, int c_) { nM = M / BM; nN = N / BM; nwg = nM * nN; G = G_; c = c_; }
  __device__ bool next(int i, Unit& u) const {
    const long L = (long)i * G + c; if (L >= nwg) return false;
    int wgid = (int)L; { const int q = nwg / NXCD, r = nwg % NXCD, xcd = wgid % NXCD, off = wgid / NXCD; wgid = (xcd < r ? xcd * (q + 1) : r * (q + 1) + (xcd - r) * q) + off; }
    const int nig = WGM * nN, gid = wgid / nig, fm = gid * WGM, gsz = (nM - fm) < WGM ? (nM - fm) : WGM;
    u.pm = fm + ((wgid % nig) % gsz); u.pn = (wgid % nig) / gsz; return true;
  }
};
template <class Epi>
__device__ __forceinline__ void gemm_phase(LAS unsigned char* lds, const Gemm g, const StaticOrder& S, const Epi& E) {
  const int tid = tidx(), wid = __builtin_amdgcn_readfirstlane(tid >> 6), lane = tid & 63, wr = wid >> 2, wc = wid & 3, fr = lane & 15, fq = lane >> 4;
  const int K = g.K, nt = K / BK, lda = g.lda;
  unsigned voffA[2], voffB[2];
#pragma unroll
  for (int i = 0; i < 2; ++i) { int R, C; stage_rc(tid * 16 + i * 8192, R, C); const int Rb = (R & ~31) + perm32(R & 31);
    voffA[i] = (unsigned)(R * lda + C) * 2u; voffB[i] = (unsigned)(Rb * K + C) * 2u; }
  const size_t kstep = (size_t)(BK * 2);
  const size_t hstepA = (size_t)HALF * lda * 2, hstepB = (size_t)HALF * K * 2;
  const size_t tstepA = 2 * hstepA, tstepB = 2 * hstepB;
  const unsigned ldsw = (unsigned)wid * 1024u;
  const int aoff = lds_byte(wr * 64 + fr, fq * 8), boff = lds_byte(wc * 32 + fr, fq * 8);
#define PG8_SA(b, h) (((b) * 2 + (h)) * HTB)
#define PG8_SB(b, h) ((4 + (b) * 2 + (h)) * HTB)
#define PG8_STAGE(bufoff, gbase, voff) do { _Pragma("unroll") for (int _i = 0; _i < 2; ++_i) \
    __builtin_amdgcn_global_load_lds((const unsigned*)((const char*)(gbase) + (voff)[_i]), (LAS unsigned*)(lds + (bufoff) + ldsw + _i * 8192), 16, 0, 0); } while (0)
#define PG8_LDA(dst, b, h) do { _Pragma("unroll") for (int m = 0; m < 4; ++m) _Pragma("unroll") for (int k = 0; k < 2; ++k) dst[m][k] = *(const LAS bf16x8*)(lds + PG8_SA(b, h) + aoff + m * 2048 + k * 1024); } while (0)
#define PG8_LDB(dst, b, h) do { _Pragma("unroll") for (int n = 0; n < 2; ++n) _Pragma("unroll") for (int k = 0; k < 2; ++k) dst[n][k] = *(const LAS bf16x8*)(lds + PG8_SB(b, h) + boff + n * 2048 + k * 1024); } while (0)
#define PG8_MMA(ai, bj, At, Bt) do { __builtin_amdgcn_s_setprio(1); _Pragma("unroll") for (int m = 0; m < 4; ++m) _Pragma("unroll") for (int n = 0; n < 2; ++n) _Pragma("unroll") for (int k = 0; k < 2; ++k) \
    acc[ai][bj][m][n] = __builtin_amdgcn_mfma_f32_16x16x32_bf16(Bt[n][k], At[m][k], acc[ai][bj][m][n], 0, 0, 0); __builtin_amdgcn_s_setprio(0); } while (0)
#define PG8_WAIT_V(n) asm volatile("s_waitcnt vmcnt(" #n ")" ::: "memory")
#define PG8_WAIT_L(n) asm volatile("s_waitcnt lgkmcnt(" #n ")" ::: "memory")
#define PG8_BAR __builtin_amdgcn_s_barrier()
#define PG8_SCHED __builtin_amdgcn_sched_barrier(0)
  Unit cur, nxt; int ui = 0;
  if (!S.next(0, cur)) return;
  f32x4 acc[2][2][4][2];
#pragma unroll
  for (int a = 0; a < 2; ++a)
#pragma unroll
    for (int b = 0; b < 2; ++b)
#pragma unroll
      for (int m = 0; m < 4; ++m)
#pragma unroll
        for (int n = 0; n < 2; ++n) acc[a][b][m][n] = (f32x4){0.f, 0.f, 0.f, 0.f};
  bf16x8 At[4][2], B0[2][2], B1[2][2];
  const char* cA = (const char*)g.A + (size_t)cur.pm * tstepA; const char* cB = (const char*)g.Bt + (size_t)cur.pn * tstepB;
  PG8_STAGE(PG8_SB(0, 0), cB, voffB); PG8_STAGE(PG8_SB(0, 1), cB + hstepB, voffB); PG8_STAGE(PG8_SA(0, 0), cA, voffA); PG8_STAGE(PG8_SA(0, 1), cA + hstepA, voffA);
  if (wr == 1) PG8_BAR;
  PG8_WAIT_V(2); PG8_BAR;
  PG8_STAGE(PG8_SB(1, 0), cB + kstep, voffB); PG8_STAGE(PG8_SA(1, 0), cA + kstep, voffA); PG8_STAGE(PG8_SB(1, 1), cB + hstepB + kstep, voffB);
  PG8_WAIT_V(6); PG8_BAR;
  for (;;) {
    const bool has_next = S.next(ui + 1, nxt);
    const char* nA = has_next ? (const char*)g.A + (size_t)nxt.pm * tstepA : cA; const char* nB = has_next ? (const char*)g.Bt + (size_t)nxt.pn * tstepB : cB;
    for (int t = 0; t < nt; t += 2) {
      const bool last = (t == nt - 2);
      const char* a1 = cA + (size_t)(t + 1) * kstep;
      const char* a2 = last ? nA : cA + (size_t)(t + 2) * kstep; const char* b2 = last ? nB : cB + (size_t)(t + 2) * kstep;
      const char* a3 = a2 + kstep; const char* b3 = b2 + kstep;
      PG8_LDB(B0, 0, 0); PG8_LDB(B1, 0, 1); PG8_SCHED; PG8_LDA(At, 0, 0); PG8_STAGE(PG8_SA(1, 1), a1 + hstepA, voffA);
      PG8_WAIT_V(8); PG8_WAIT_L(0); PG8_BAR; PG8_MMA(0, 0, At, B0); PG8_MMA(0, 1, At, B1); PG8_BAR; PG8_SCHED;
      PG8_LDA(At, 0, 1); PG8_STAGE(PG8_SB(0, 0), b2, voffB); PG8_STAGE(PG8_SB(0, 1), b2 + hstepB, voffB); PG8_STAGE(PG8_SA(0, 0), a2, voffA);
      PG8_WAIT_V(8); PG8_WAIT_L(0); PG8_BAR; PG8_MMA(1, 0, At, B0); PG8_MMA(1, 1, At, B1); PG8_BAR; PG8_SCHED;
      PG8_LDB(B0, 1, 0); PG8_LDB(B1, 1, 1); PG8_SCHED; PG8_LDA(At, 1, 0); PG8_STAGE(PG8_SA(0, 1), a2 + hstepA, voffA);
      PG8_WAIT_V(8); PG8_WAIT_L(0); PG8_BAR; PG8_MMA(0, 0, At, B0); PG8_MMA(0, 1, At, B1); PG8_BAR; PG8_SCHED;
      PG8_LDA(At, 1, 1); PG8_STAGE(PG8_SB(1, 0), b3, voffB); PG8_STAGE(PG8_SB(1, 1), b3 + hstepB, voffB); PG8_STAGE(PG8_SA(1, 0), a3, voffA);
      PG8_WAIT_V(8); PG8_WAIT_L(0); PG8_BAR; PG8_MMA(1, 0, At, B0); PG8_MMA(1, 1, At, B1); PG8_BAR; PG8_SCHED;
    }
    if (wr == 0) PG8_BAR;
    E(acc, cur, wr, wc, fr, fq);
    if (!has_next) break;
#pragma unroll
    for (int a = 0; a < 2; ++a)
#pragma unroll
      for (int b = 0; b < 2; ++b)
#pragma unroll
        for (int m = 0; m < 4; ++m)
#pragma unroll
          for (int n = 0; n < 2; ++n) acc[a][b][m][n] = (f32x4){0.f, 0.f, 0.f, 0.f};
    cur = nxt; cA = nA; cB = nB; ++ui;
    if (wr == 1) PG8_BAR;
  }
  PG8_WAIT_V(0);
  PG8_BAR;
#undef PG8_SA
#undef PG8_SB
#undef PG8_STAGE
#undef PG8_LDA
#undef PG8_LDB
#undef PG8_MMA
#undef PG8_WAIT_V
#undef PG8_WAIT_L
#undef PG8_BAR
#undef PG8_SCHED
}

struct EpiBf16 {
  bf16_t* O; int ldc;
  __device__ __forceinline__ void operator()(const f32x4 (&acc)[2][2][4][2], const Unit& u, int wr, int wc, int fr, int fq) const {
    const int row0 = u.pm * BM + wr * 64 + fr, col0 = u.pn * BM + wc * 32 + 8 * fq;
#pragma unroll
    for (int ai = 0; ai < 2; ++ai)
#pragma unroll
      for (int m = 0; m < 4; ++m) { bf16_t* rowp = O + (size_t)(row0 + ai * HALF + m * 16) * ldc + col0;
#pragma unroll
        for (int bj = 0; bj < 2; ++bj) { const f32x4 v0 = acc[ai][bj][m][0], v1 = acc[ai][bj][m][1];
          u32x4 w; w.x = cvt_pk_bf16(v0[0], v0[1]); w.y = cvt_pk_bf16(v0[2], v0[3]); w.z = cvt_pk_bf16(v1[0], v1[1]); w.w = cvt_pk_bf16(v1[2], v1[3]);
          *(u32x4*)(rowp + bj * HALF) = w; } }
  }
};
struct EpiSwiGLU {
  bf16_t* O;
  __device__ __forceinline__ void operator()(const f32x4 (&acc)[2][2][4][2], const Unit& u, int wr, int wc, int fr, int fq) const {
    const int row0 = u.pm * BM + wr * 64 + fr, col0 = u.pn * 128 + wc * 16 + 4 * fq;
#pragma unroll
    for (int ai = 0; ai < 2; ++ai)
#pragma unroll
      for (int m = 0; m < 4; ++m) { bf16_t* rowp = O + (size_t)(row0 + ai * HALF + m * 16) * FF + col0;
#pragma unroll
        for (int bj = 0; bj < 2; ++bj) { const f32x4 gt = acc[ai][bj][m][0], up = acc[ai][bj][m][1];
          u32x2 w; w.x = cvt_pk_bf16(silu_f(gt[0]) * up[0], silu_f(gt[1]) * up[1]); w.y = cvt_pk_bf16(silu_f(gt[2]) * up[2], silu_f(gt[3]) * up[3]);
          *(u32x2*)(rowp + bj * 64) = w; } }
  }
};
struct EpiResid {
  float* H; float alpha;
  __device__ __forceinline__ void operator()(const f32x4 (&acc)[2][2][4][2], const Unit& u, int wr, int wc, int fr, int fq) const {
    const int row0 = u.pm * BM + wr * 64 + fr, col0 = u.pn * BM + wc * 32 + 8 * fq;
#pragma unroll
    for (int ai = 0; ai < 2; ++ai)
#pragma unroll
      for (int m = 0; m < 4; ++m) { float* rowp = H + (size_t)(row0 + ai * HALF + m * 16) * DM + col0;
#pragma unroll
        for (int bj = 0; bj < 2; ++bj) { f32x4* p = (f32x4*)(rowp + bj * HALF);
          f32x4 a = p[0], b = p[1]; a += acc[ai][bj][m][0] * alpha; b += acc[ai][bj][m][1] * alpha; p[0] = a; p[1] = b; } }
  }
};
struct EpiRet {
  bf16_t* RQ; bf16_t* RK; bf16_t* RKT; bf16_t* RV; bf16_t* RG; const float* ctab; const float* stab; int seqmask;
  __device__ __forceinline__ void operator()(const f32x4 (&acc)[2][2][4][2], const Unit& u, int wr, int wc, int fr, int fq) const {
    const int row0 = u.pm * BM + wr * 64 + fr; const int pn = u.pn; const int cin = wc * 32 + 8 * fq;
    if (pn < 8) {
      const bool isk = pn >= 4; const int head = pn & 3; const float sc = isk ? 0.0625f : 1.f;
      bf16_t* dst = isk ? RK : RQ;
#pragma unroll
      for (int ai = 0; ai < 2; ++ai)
#pragma unroll
        for (int m = 0; m < 4; ++m) { const int lr = row0 + ai * HALF + m * 16; const int pos = lr & seqmask;
          const float* cp = ctab + (size_t)pos * 128 + cin; const float* sp = stab + (size_t)pos * 128 + cin;
          float o1[8], o2[8];
#pragma unroll
          for (int n = 0; n < 2; ++n) { const f32x4 c4 = *(const f32x4*)(cp + 4 * n), s4 = *(const f32x4*)(sp + 4 * n); const f32x4 x1 = acc[ai][0][m][n], x2 = acc[ai][1][m][n];
#pragma unroll
            for (int j = 0; j < 4; ++j) { o1[4 * n + j] = (x1[j] * c4[j] - x2[j] * s4[j]) * sc; o2[4 * n + j] = (x2[j] * c4[j] + x1[j] * s4[j]) * sc; } }
          u32x4 w1, w2; w1.x = cvt_pk_bf16(o1[0], o1[1]); w1.y = cvt_pk_bf16(o1[2], o1[3]); w1.z = cvt_pk_bf16(o1[4], o1[5]); w1.w = cvt_pk_bf16(o1[6], o1[7]);
          w2.x = cvt_pk_bf16(o2[0], o2[1]); w2.y = cvt_pk_bf16(o2[2], o2[3]); w2.z = cvt_pk_bf16(o2[4], o2[5]); w2.w = cvt_pk_bf16(o2[6], o2[7]);
          bf16_t* rp = dst + (size_t)lr * 1024 + head * 256 + cin;
          *(u32x4*)rp = w1; *(u32x4*)(rp + 128) = w2;
          if (isk) { bf16_t* tp = RKT + ((size_t)((lr >> 6) * 4 + head) * 256 + cin) * 64 + (lr & 63);
#pragma unroll
            for (int e = 0; e < 8; ++e) { tp[(size_t)e * 64] = f2bf(o1[e]); tp[(size_t)(e + 128) * 64] = f2bf(o2[e]); } }
        }
    } else {
      const bool isg = pn >= 16; bf16_t* dst = isg ? RG : RV; const int cbase = (isg ? pn - 16 : pn - 8) * 256 + cin;
#pragma unroll
      for (int ai = 0; ai < 2; ++ai)
#pragma unroll
        for (int m = 0; m < 4; ++m) { bf16_t* rowp = dst + (size_t)(row0 + ai * HALF + m * 16) * 2048 + cbase;
#pragma unroll
          for (int bj = 0; bj < 2; ++bj) { f32x4 v0 = acc[ai][bj][m][0], v1 = acc[ai][bj][m][1];
            if (isg) {
#pragma unroll
              for (int j = 0; j < 4; ++j) { v0[j] = silu_f(v0[j]); v1[j] = silu_f(v1[j]); } }
            u32x4 w; w.x = cvt_pk_bf16(v0[0], v0[1]); w.y = cvt_pk_bf16(v0[2], v0[3]); w.z = cvt_pk_bf16(v1[0], v1[1]); w.w = cvt_pk_bf16(v1[2], v1[3]);
            *(u32x4*)(rowp + bj * HALF) = w; } }
    }
  }
};
}

namespace att {
constexpr int KVBLK = 64;
constexpr float SCALE = 0.07216878364870323f;
constexpr float THR = 8.f;
constexpr int SHM_K = KVBLK * 192 * 2, SHM_V = KVBLK * 128 * 2;
#define KSWZ(row, colB) ((row) * 384 + ((colB) ^ (((row) & 7) << 4)))
#define SBAR() __builtin_amdgcn_sched_barrier(0)
__device__ __forceinline__ int crow(int r, int hi) { return (r & 3) + 8 * (r >> 2) + 4 * hi; }
__device__ __forceinline__ void partialSM(f32x16& p0, f32x16& p1, float& m_reg, float& mn, float& alpha) {
  constexpr float C = SCALE * 1.4426950408889634f;
  float pmax = p0[0];
#pragma unroll
  for (int r = 1; r < 16; ++r) pmax = fmaxf(pmax, p0[r]);
#pragma unroll
  for (int r = 0; r < 16; ++r) pmax = fmaxf(pmax, p1[r]);
  { auto rr = __builtin_amdgcn_permlane32_swap(__float_as_uint(pmax), __float_as_uint(pmax), false, false);
    pmax = fmaxf(__uint_as_float(rr[0]), __uint_as_float(rr[1])); }
  if (__builtin_expect(__all(pmax - m_reg <= THR / SCALE), 1)) { mn = m_reg; alpha = 1.f; }
  else { mn = fmaxf(m_reg, pmax); alpha = __builtin_amdgcn_exp2f((m_reg - mn) * C); m_reg = mn; }
  const float mnC = -mn * C;
#pragma unroll
  for (int r = 0; r < 16; ++r) p0[r] = __builtin_amdgcn_exp2f(fmaf(p0[r], C, mnC));
#pragma unroll
  for (int r = 0; r < 16; ++r) p1[r] = __builtin_amdgcn_exp2f(fmaf(p1[r], C, mnC));
}
__device__ __forceinline__ void finishSM(f32x16& p0, f32x16& p1, float alpha, float& l_reg, bf16x8& pa0, bf16x8& pa1, bf16x8& pa2, bf16x8& pa3) {
  float ps = 0;
#pragma unroll
  for (int r = 0; r < 16; ++r) ps += p0[r];
#pragma unroll
  for (int r = 0; r < 16; ++r) ps += p1[r];
  { auto rr = __builtin_amdgcn_permlane32_swap(__float_as_uint(ps), __float_as_uint(ps), false, false);
    ps = __uint_as_float(rr[0]) + __uint_as_float(rr[1]); }
  l_reg = l_reg * alpha + ps;
#define PK4(P, BASE, OUT) do { unsigned a0 = cvt_pk_bf16(P[BASE + 0], P[BASE + 1]), a1 = cvt_pk_bf16(P[BASE + 2], P[BASE + 3]);   \
    unsigned b0 = cvt_pk_bf16(P[BASE + 4], P[BASE + 5]), b1 = cvt_pk_bf16(P[BASE + 6], P[BASE + 7]);                              \
    auto r0 = __builtin_amdgcn_permlane32_swap(a0, b0, false, false); auto r1 = __builtin_amdgcn_permlane32_swap(a1, b1, false, false); \
    u32x4 w = {r0[0], r1[0], r0[1], r1[1]}; OUT = *reinterpret_cast<bf16x8*>(&w); } while (0)
  PK4(p0, 0, pa0); PK4(p0, 8, pa1); PK4(p1, 0, pa2); PK4(p1, 8, pa3);
#undef PK4
}
__device__ __forceinline__ void qkt(f32x16& p0, f32x16& p1, const char* Ks, const bf16x8* qr, int r32, int hi) {
  p0 = f32x16{}; p1 = f32x16{};
#pragma unroll
  for (int d0 = 0; d0 < 12; ++d0) { const int cb = (d0 * 16 + hi * 8) * 2;
    const bf16x8 b0 = *reinterpret_cast<const bf16x8*>(Ks + KSWZ(r32, cb));
    const bf16x8 b1 = *reinterpret_cast<const bf16x8*>(Ks + KSWZ(32 + r32, cb));
    p0 = __builtin_amdgcn_mfma_f32_32x32x16_bf16(b0, qr[d0], p0, 0, 0, 0);
    p1 = __builtin_amdgcn_mfma_f32_32x32x16_bf16(b1, qr[d0], p1, 0, 0, 0); }
}
__device__ __forceinline__ int v_st(int k, int c) { const int kk = (k & ~0xC) | ((k & 4) << 1) | ((k & 8) >> 1); return ((kk >> 3) * 4 + (c >> 5)) * 512 + ((kk & 7) * 32 + (c & 31)) * 2; }
__device__ __forceinline__ int v_rd_base(int lane) { return ((lane & 3) << 3) | (((lane >> 2) & 3) << 6) | (((lane >> 4) & 1) << 5) | (((lane >> 5) & 1) << 8); }
constexpr int v_rd_off(int d0, int ks, int half) { return d0 * 512 + ks * 4096 + half * 2048; }
template <int OFF> __device__ __forceinline__ s16x4 tr_read(int vb) {
  s16x4 r; asm volatile("ds_read_b64_tr_b16 %0, %1 offset:%2" : "=&v"(r) : "v"(vb), "i"(OFF) : "memory"); return r;
}
template <int D0> __device__ __forceinline__ void pv_one(f32x16& od, int vb, bf16x8 pa0, bf16x8 pa1, bf16x8 pa2, bf16x8 pa3) {
  const s16x4 l0 = tr_read<v_rd_off(D0, 0, 0)>(vb), h0 = tr_read<v_rd_off(D0, 0, 1)>(vb), l1 = tr_read<v_rd_off(D0, 1, 0)>(vb), h1 = tr_read<v_rd_off(D0, 1, 1)>(vb);
  const s16x4 l2 = tr_read<v_rd_off(D0, 2, 0)>(vb), h2 = tr_read<v_rd_off(D0, 2, 1)>(vb), l3 = tr_read<v_rd_off(D0, 3, 0)>(vb), h3 = tr_read<v_rd_off(D0, 3, 1)>(vb);
  asm volatile("s_waitcnt lgkmcnt(0)" ::: "memory"); SBAR();
#define PK(L, H) (bf16x8){L[0], L[1], L[2], L[3], H[0], H[1], H[2], H[3]}
  od = __builtin_amdgcn_mfma_f32_32x32x16_bf16(pa0, PK(l0, h0), od, 0, 0, 0);
  od = __builtin_amdgcn_mfma_f32_32x32x16_bf16(pa1, PK(l1, h1), od, 0, 0, 0);
  od = __builtin_amdgcn_mfma_f32_32x32x16_bf16(pa2, PK(l2, h2), od, 0, 0, 0);
  od = __builtin_amdgcn_mfma_f32_32x32x16_bf16(pa3, PK(l3, h3), od, 0, 0, 0);
#undef PK
}
__device__ __forceinline__ void pv_d0(f32x16* o, int vb, bf16x8 pa0, bf16x8 pa1, bf16x8 pa2, bf16x8 pa3) {
  pv_one<0>(o[0], vb, pa0, pa1, pa2, pa3); pv_one<1>(o[1], vb, pa0, pa1, pa2, pa3); pv_one<2>(o[2], vb, pa0, pa1, pa2, pa3); pv_one<3>(o[3], vb, pa0, pa1, pa2, pa3);
}
__device__ __forceinline__ void attn_unit(const bf16_t* __restrict__ Qb, const bf16_t* __restrict__ KVh, const bf16_t* __restrict__ KPEh, bf16_t* __restrict__ Ob, int seq, char* lds, int ldsoff) {
  const int tid = tidx(), wid = tid >> 6, lane = tid & 63, r32 = lane & 31, hi = lane >> 5;
  char* V_lds = lds; char* K_lds = lds + 2 * SHM_V;
  float* ws = (float*)(lds + 2 * SHM_V + 2 * SHM_K) + wid * 64; float* li_l = ws; float* al_l = ws + 32;
  float m_reg = -1e30f, l_reg = 0; f32x16 o[4] = {}; bf16x8 qr[12];
  const bf16_t* Qw = Qb + (long)(wid * 32 + r32) * 1536 + hi * 8;
#pragma unroll
  for (int d0 = 0; d0 < 12; ++d0) qr[d0] = *reinterpret_cast<const bf16x8*>(Qw + d0 * 16);
  const int sr = tid >> 4, sc = (tid & 15) * 8, vst0 = v_st(sr, sc), vst1 = v_st(32 + sr, sc);
  const int pr = tid >> 3, pc = (tid & 7) * 8;
  const int vb0 = ldsoff + v_rd_base(lane);
  bf16x8 vs0, vs1, ks0, ks1, kp;
#define SLOAD(k0) do { vs0 = *reinterpret_cast<const bf16x8*>(&KVh[(long)((k0) + sr) * 2048 + 128 + sc]); vs1 = *reinterpret_cast<const bf16x8*>(&KVh[(long)((k0) + 32 + sr) * 2048 + 128 + sc]); \
    ks0 = *reinterpret_cast<const bf16x8*>(&KVh[(long)((k0) + sr) * 2048 + sc]); ks1 = *reinterpret_cast<const bf16x8*>(&KVh[(long)((k0) + 32 + sr) * 2048 + sc]); \
    kp = *reinterpret_cast<const bf16x8*>(&KPEh[(long)((k0) + pr) * 512 + pc]); } while (0)
#define SWRITE(b) do { *(bf16x8*)(V_lds + (b) * SHM_V + vst0) = vs0; *(bf16x8*)(V_lds + (b) * SHM_V + vst1) = vs1; \
    *(bf16x8*)(K_lds + (b) * SHM_K + KSWZ(sr, sc * 2)) = ks0; *(bf16x8*)(K_lds + (b) * SHM_K + KSWZ(32 + sr, sc * 2)) = ks1; \
    *(bf16x8*)(K_lds + (b) * SHM_K + KSWZ(pr, (128 + pc) * 2)) = kp; } while (0)
  f32x16 p0, p1; float mn, al; bf16x8 pa0, pa1, pa2, pa3; const int NT = seq / KVBLK;
  SLOAD(0); asm volatile("s_waitcnt vmcnt(0)" ::: "memory"); SWRITE(0); __syncthreads();
  for (int j = 0; j < NT; ++j) {
    const int b = j & 1;
    if (j + 1 < NT) SLOAD((j + 1) * KVBLK);
    SBAR();
    qkt(p0, p1, K_lds + b * SHM_K, qr, r32, hi);
    partialSM(p0, p1, m_reg, mn, al);
    if (__any(al < 1.f)) { if (hi == 0) al_l[r32] = al; asm volatile("s_waitcnt lgkmcnt(0)" ::: "memory");
#pragma unroll
      for (int d = 0; d < 4; ++d)
#pragma unroll
        for (int r = 0; r < 16; ++r) o[d][r] *= al_l[crow(r, hi)]; }
    finishSM(p0, p1, al, l_reg, pa0, pa1, pa2, pa3); SBAR();
    pv_d0(o, vb0 + b * SHM_V, pa0, pa1, pa2, pa3);
    if (j + 1 < NT) { asm volatile("s_waitcnt vmcnt(0)" ::: "memory"); SWRITE(b ^ 1); }
    __syncthreads();
  }
  if (hi == 0) li_l[r32] = l_reg; asm volatile("s_waitcnt lgkmcnt(0)" ::: "memory");
  float rli[16];
#pragma unroll
  for (int r = 0; r < 16; ++r) rli[r] = __builtin_amdgcn_rcpf(li_l[crow(r, hi)]);
  bf16_t* Ow = Ob + (long)(wid * 32) * 1024;
#pragma unroll
  for (int r = 0; r < 16; ++r) { const int orow = crow(r, hi);
#pragma unroll
    for (int d0 = 0; d0 < 4; ++d0) Ow[(long)orow * 1024 + d0 * 32 + r32] = f2bf(o[d0][r] * rli[r]); }
  __syncthreads();
#undef SLOAD
#undef SWRITE
}
}

namespace ret {
constexpr int RS = 528, TS = 144;
constexpr int QS = 0, KS = 33792;
constexpr int KTS = 0, STS = 36864, PS = 53760, VTS = 62976, VZS = 67584;
__device__ __forceinline__ f32x4 mma16(bf16x8 a, bf16x8 b, f32x4 c) { return __builtin_amdgcn_mfma_f32_16x16x32_bf16(a, b, c, 0, 0, 0); }
__device__ __forceinline__ void p_unit(LAS unsigned char* L, const bf16_t* __restrict__ RQ, const bf16_t* __restrict__ RK, bf16_t* __restrict__ Pg, int c, int hd, float lg2f, float lg2b) {
  const int tid = tidx(), wid = tid >> 6, lane = tid & 63, l15 = lane & 15, g4 = lane >> 4;
  const int it = wid >> 1, jt0 = 2 * (wid & 1);
  const long tok0 = (long)c * 64;
#pragma unroll
  for (int i = 0; i < 4; ++i) { const int q = tid + 512 * i; const int row = q >> 5, c16 = q & 31;
    const u32x4 a = *(const u32x4*)(RQ + (tok0 + row) * 1024 + hd * 256 + c16 * 8), b = *(const u32x4*)(RK + (tok0 + row) * 1024 + hd * 256 + c16 * 8);
    *(LAS u32x4*)(L + QS + row * RS + c16 * 16) = a; *(LAS u32x4*)(L + KS + row * RS + c16 * 16) = b; }
  __syncthreads();
  f32x4 sS0 = {0.f, 0.f, 0.f, 0.f}, sS1 = {0.f, 0.f, 0.f, 0.f};
#pragma unroll
  for (int ks = 0; ks < 8; ++ks) { const int ko = (ks * 32 + 8 * g4) * 2;
    const bf16x8 a = *(const LAS bf16x8*)(L + QS + (16 * it + l15) * RS + ko);
    const bf16x8 b0 = *(const LAS bf16x8*)(L + KS + (16 * jt0 + l15) * RS + ko);
    const bf16x8 b1 = *(const LAS bf16x8*)(L + KS + (16 * (jt0 + 1) + l15) * RS + ko);
    sS0 = mma16(a, b0, sS0); sS1 = mma16(a, b1, sS1); }
  bf16_t* Pf = Pg + ((size_t)(c * 4 + hd) * 2) * 4096; bf16_t* Pb = Pf + 4096;
#pragma unroll
  for (int r = 0; r < 4; ++r) { const int i = 16 * it + 4 * g4 + r; const int j0 = 16 * jt0 + l15, j1 = j0 + 16;
    const float f0 = (i >= j0) ? __builtin_amdgcn_exp2f((float)(i - j0) * lg2f) : 0.f, f1 = (i >= j1) ? __builtin_amdgcn_exp2f((float)(i - j1) * lg2f) : 0.f;
    const float b0 = (j0 > i) ? __builtin_amdgcn_exp2f((float)(j0 - i) * lg2b) : 0.f, b1 = (j1 > i) ? __builtin_amdgcn_exp2f((float)(j1 - i) * lg2b) : 0.f;
    Pf[i * 64 + j0] = f2bf(sS0[r] * f0); Pf[i * 64 + j1] = f2bf(sS1[r] * f1);
    Pb[i * 64 + j0] = f2bf(sS0[r] * b0); Pb[i * 64 + j1] = f2bf(sS1[r] * b1); }
  __syncthreads();
}
__device__ __forceinline__ void scan_item(LAS unsigned char* L, const bf16_t* __restrict__ RQ, const bf16_t* __restrict__ RKT, const bf16_t* __restrict__ RV, const bf16_t* __restrict__ Pg,
                                          bf16_t* __restrict__ Oo, int seqlen, int s, int hd, int dir, int sl, float lg2) {
  const int tid = tidx(), wid = tid >> 6, lane = tid & 63, l15 = lane & 15, g4 = lane >> 4;
  const int nchunk = seqlen >> 6;
  const int it = wid >> 1, vt = wid & 1;
  f32x4 st[2][2];
#pragma unroll
  for (int a = 0; a < 2; ++a)
#pragma unroll
    for (int b = 0; b < 2; ++b) st[a][b] = (f32x4){0.f, 0.f, 0.f, 0.f};
  const float gch = __builtin_amdgcn_exp2f(64.f * lg2);
  bf16x8 qfA[8], qfB[8]; u32x4 ptA[4], ptB[4], pvA, pvB, ppA, ppB;
  const int vrow = tid >> 2, vc4 = tid & 3;
#define RLOAD_STAGE(PT, PV, PP, c) do { const long tok0 = (long)s * seqlen + (long)(c) * 64; \
    _Pragma("unroll") for (int i = 0; i < 4; ++i) PT[i] = *(const u32x4*)(RKT + (((tok0 >> 6) * 4 + hd) * 256) * 64 + (long)(tid + 512 * i) * 8); \
    PP = *(const u32x4*)(Pg + ((size_t)((tok0 >> 6) * 4 + hd) * 2 + dir) * 4096 + tid * 8); \
    if (tid < 256) PV = *(const u32x4*)(RV + (tok0 + vrow) * 2048 + hd * 512 + sl * 32 + vc4 * 8); } while (0)
#define RLOAD_Q(QF, c) do { const long tok0 = (long)s * seqlen + (long)(c) * 64; const bf16_t* qb_ = RQ + (tok0 + 16 * it + l15) * 1024 + hd * 256 + 8 * g4; \
    _Pragma("unroll") for (int ks = 0; ks < 8; ++ks) QF[ks] = *(const bf16x8*)(qb_ + ks * 32); } while (0)
#define CHUNK_OF(cc_) (dir ? nchunk - 1 - (cc_) : (cc_))
#define SCAN_STEP(QF, PT, PV, PP, CC) do { \
    const int c = CHUNK_OF(CC); \
    _Pragma("unroll") for (int i = 0; i < 4; ++i) { const int q = tid + 512 * i; const int dr = q >> 3, c8 = q & 7; *(LAS u32x4*)(L + KTS + dr * TS + c8 * 16) = PT[i]; } \
    *(LAS u32x4*)(L + PS + (tid >> 3) * TS + (tid & 7) * 16) = PP; \
    if (tid < 256) { const float zeta = __builtin_amdgcn_exp2f((dir ? (float)vrow : (float)(63 - vrow)) * lg2); \
      const unsigned wv[4] = {PV.x, PV.y, PV.z, PV.w}; \
      _Pragma("unroll") for (int e = 0; e < 8; ++e) { const unsigned w = wv[e >> 1]; const unsigned short raw = (e & 1) ? (unsigned short)(w >> 16) : (unsigned short)(w & 0xffffu); \
        const int dv = vc4 * 8 + e; \
        *(LAS unsigned short*)(L + VTS + dv * TS + vrow * 2) = raw; \
        *(LAS unsigned short*)(L + VZS + dv * TS + vrow * 2) = f2bf(bf2f(raw) * zeta); } } \
    _Pragma("unroll") for (int a = 0; a < 2; ++a) _Pragma("unroll") for (int b = 0; b < 2; ++b) { const int d = 16 * (2 * wid + a) + 4 * g4, dv = 16 * b + l15; \
        u32x2 w; w.x = cvt_pk_bf16(st[a][b][0], st[a][b][1]); w.y = cvt_pk_bf16(st[a][b][2], st[a][b][3]); \
        *(LAS u32x2*)(L + STS + dv * RS + d * 2) = w; } \
    __syncthreads(); \
    if ((CC) + 2 < nchunk) RLOAD_STAGE(PT, PV, PP, CHUNK_OF((CC) + 2)); \
    f32x4 cX = {0.f, 0.f, 0.f, 0.f}; \
    _Pragma("unroll") for (int ks = 0; ks < 8; ++ks) { const bf16x8 b2 = *(const LAS bf16x8*)(L + STS + (16 * vt + l15) * RS + (ks * 32 + 8 * g4) * 2); cX = mma16(QF[ks], b2, cX); } \
    if ((CC) + 2 < nchunk) RLOAD_Q(QF, CHUNK_OF((CC) + 2)); \
    _Pragma("unroll") for (int r = 0; r < 4; ++r) { const int i = 16 * it + 4 * g4 + r; cX[r] *= __builtin_amdgcn_exp2f((dir ? (float)(64 - i) : (float)(i + 1)) * lg2); } \
    _Pragma("unroll") for (int a = 0; a < 2; ++a) _Pragma("unroll") for (int b = 0; b < 2; ++b) st[a][b] *= gch; \
    _Pragma("unroll") for (int ks = 0; ks < 2; ++ks) { const int ko = (ks * 32 + 8 * g4) * 2; \
      const bf16x8 a0 = *(const LAS bf16x8*)(L + KTS + (16 * (2 * wid) + l15) * TS + ko); \
      const bf16x8 a1 = *(const LAS bf16x8*)(L + KTS + (16 * (2 * wid + 1) + l15) * TS + ko); \
      const bf16x8 b0 = *(const LAS bf16x8*)(L + VZS + (l15) * TS + ko); \
      const bf16x8 b1 = *(const LAS bf16x8*)(L + VZS + (16 + l15) * TS + ko); \
      st[0][0] = mma16(a0, b0, st[0][0]); st[0][1] = mma16(a0, b1, st[0][1]); st[1][0] = mma16(a1, b0, st[1][0]); st[1][1] = mma16(a1, b1, st[1][1]); } \
    _Pragma("unroll") for (int ks = 0; ks < 2; ++ks) { const int ko = (ks * 32 + 8 * g4) * 2; \
      const bf16x8 a = *(const LAS bf16x8*)(L + PS + (16 * it + l15) * TS + ko); \
      const bf16x8 b = *(const LAS bf16x8*)(L + VTS + (16 * vt + l15) * TS + ko); \
      cX = mma16(a, b, cX); } \
    { const long tok0 = (long)s * seqlen + (long)c * 64; \
      _Pragma("unroll") for (int r = 0; r < 4; ++r) { const int i = 16 * it + 4 * g4 + r; \
        Oo[((long)(hd * 16 + sl) * T_GRP + tok0 + i) * 32 + 16 * vt + l15] = f2bf(cX[r]); } } \
    __syncthreads(); } while (0)
  RLOAD_STAGE(ptA, pvA, ppA, CHUNK_OF(0)); RLOAD_Q(qfA, CHUNK_OF(0));
  RLOAD_STAGE(ptB, pvB, ppB, CHUNK_OF(1)); RLOAD_Q(qfB, CHUNK_OF(1));
#pragma unroll 1
  for (int cc = 0; cc < nchunk; cc += 2) {
    SCAN_STEP(qfA, ptA, pvA, ppA, cc);
    SCAN_STEP(qfB, ptB, pvB, ppB, cc + 1);
  }
#undef SCAN_STEP
#undef CHUNK_OF
#undef RLOAD_STAGE
#undef RLOAD_Q
}
}

__device__ __forceinline__ void prep_T(float* tile, const float* __restrict__ W, int K, int N, bf16_t* __restrict__ Bt, int mode, int row_off, int& base) {
  const int G = gridDim.x, tid = tidx();
  const int tn = N >> 6, ntile = (K >> 6) * tn;
  int t0 = ((int)blockIdx.x - base % G + G) % G;
  for (int t = t0; t < ntile; t += G) {
    const int k0 = (t / tn) << 6, n0 = (t % tn) << 6;
#pragma unroll
    for (int i = 0; i < 2; ++i) { const int kr = (tid >> 4) + 32 * i, nc = (tid & 15) * 4;
      const f32x4 v = *(const f32x4*)(W + (size_t)(k0 + kr) * N + n0 + nc);
      tile[kr * 65 + nc] = v[0]; tile[kr * 65 + nc + 1] = v[1]; tile[kr * 65 + nc + 2] = v[2]; tile[kr * 65 + nc + 3] = v[3]; }
    __syncthreads();
    { const int n = tid >> 3, kc = (tid & 7) * 8; const int nn = n0 + n;
      const int orow = (mode == 0 ? nn : ((nn >> 2) * 8 + (nn & 3))) + row_off;
      u32x4 w;
      w.x = cvt_pk_bf16(tile[(kc + 0) * 65 + n], tile[(kc + 1) * 65 + n]); w.y = cvt_pk_bf16(tile[(kc + 2) * 65 + n], tile[(kc + 3) * 65 + n]);
      w.z = cvt_pk_bf16(tile[(kc + 4) * 65 + n], tile[(kc + 5) * 65 + n]); w.w = cvt_pk_bf16(tile[(kc + 6) * 65 + n], tile[(kc + 7) * 65 + n]);
      *(u32x4*)(Bt + (size_t)orow * K + k0 + kc) = w; }
    __syncthreads();
  }
  base += ntile;
}
__device__ __forceinline__ void prep_layer(float* tile, const Params& P, int layer) {
  bf16_t* Wb = (bf16_t*)(P.ws + WS_W); int base = 0; const int j = layer >> 1;
#pragma unroll 1
  for (int s = 0; s < 2; ++s) {
    const size_t off = (size_t)(layer * 2 + s) * DM * FF;
    bf16_t* gu = Wb + (s ? WE_GU1 : WE_GU0); bf16_t* dn = Wb + (s ? WE_D1 : WE_D0);
    prep_T(tile, P.ffn_g + off, DM, FF, gu, 1, 0, base);
    prep_T(tile, P.ffn_u + off, DM, FF, gu, 1, 4, base);
    prep_T(tile, P.ffn_d + off, FF, DM, dn, 0, 0, base);
  }
  if ((layer & 1) == 0) {
    prep_T(tile, P.m_dq + (size_t)j * 1024 * 384, 1024, 384, Wb + WE_DQKV, 0, 0, base);
    prep_T(tile, P.m_dkv + (size_t)j * 1024 * 320, 1024, 320, Wb + WE_DQKV, 0, 384, base);
    prep_T(tile, P.m_uq + (size_t)j * 384 * 1536, 384, 1536, Wb + WE_UQ, 0, 0, base);
    prep_T(tile, P.m_ukv + (size_t)j * 256 * 2048, 256, 2048, Wb + WE_UKV, 0, 0, base);
    prep_T(tile, P.m_wo + (size_t)j * 1024 * 1024, 1024, 1024, Wb + WE_MO, 0, 0, base);
    bf16_t* z = Wb + WE_DQKV + (size_t)704 * 1024;
    for (int i = blockIdx.x * 512 + tidx(); i < 64 * 1024 / 8; i += gridDim.x * 512) *(u32x4*)(z + (size_t)i * 8) = (u32x4){0u, 0u, 0u, 0u};
  } else {
    prep_T(tile, P.r_in + (size_t)j * 1024 * 6144, 1024, 6144, Wb + WE_RIN, 0, 0, base);
    prep_T(tile, P.r_wo + (size_t)j * 2048 * 1024, 2048, 1024, Wb + WE_RO, 0, 0, base);
  }
}
__device__ __forceinline__ void build_tables(const Params& P) {
  float* c64 = (float*)(P.ws + WS_TAB); float* s64 = c64 + 8192 * 32; float* c256 = s64 + 8192 * 32; float* s256 = c256 + 8192 * 128;
  const int lane = tidx() & 63, gw = blockIdx.x * 8 + (tidx() >> 6), nw = gridDim.x * 8;
  for (int pos = gw; pos < 8192; pos += nw)
  for (int k = lane; k < 160; k += 64) {
    double rb = (k < 32) ? 0.7498942093324559 : 0.930572040929699; int e = (k < 32) ? k : k - 32; double inv = 1.0;
#pragma unroll 1
    for (; e > 0; e >>= 1) { if (e & 1) inv *= rb; rb *= rb; }
    const double rev = (double)pos * inv * 0.15915494309189535;
    const float f = (float)(rev - rint(rev));
    const float c = __builtin_amdgcn_cosf(f), s = __builtin_amdgcn_sinf(f);
    if (k < 32) { c64[pos * 32 + k] = c; s64[pos * 32 + k] = s; } else { c256[pos * 128 + k - 32] = c; s256[pos * 128 + k - 32] = s; }
  }
}
__device__ __forceinline__ void rows_norm(int mode, const Params& P, const float* __restrict__ g1, const float* __restrict__ g2) {
  float* H = P.out; bf16_t* XN = (bf16_t*)(P.ws + WS_XN);
  const int lane = tidx() & 63, gw = blockIdx.x * 8 + (tidx() >> 6), nw = gridDim.x * 8;
  for (int row0 = gw; row0 < T_ALL; row0 += 2 * nw) {
    f32x4 vv[2][4];
#pragma unroll
    for (int h = 0; h < 2; ++h) { const int row = row0 + h * nw; if (row < T_ALL) {
        const float* src = (mode == 0) ? (row < T_GRP ? P.xp + (size_t)row * DM : P.xs + (size_t)(row - T_GRP) * DM) : H + (size_t)row * DM;
#pragma unroll
        for (int i = 0; i < 4; ++i) vv[h][i] = *(const f32x4*)(src + i * 256 + lane * 4); } }
#pragma unroll
    for (int h = 0; h < 2; ++h) { const int row = row0 + h * nw; if (row >= T_ALL) continue;
      f32x4 v[4]; float ss = 0.f;
#pragma unroll
      for (int i = 0; i < 4; ++i) { v[i] = vv[h][i]; ss += v[i][0] * v[i][0] + v[i][1] * v[i][1] + v[i][2] * v[i][2] + v[i][3] * v[i][3]; }
      ss = wave_sum(ss); const float rstd = rsqrtf(ss * (1.f / DM) + EPS);
      if (mode == 0) {
#pragma unroll
        for (int i = 0; i < 4; ++i) *(f32x4*)(H + (size_t)row * DM + i * 256 + lane * 4) = v[i]; }
      float ss2 = 0.f;
#pragma unroll
      for (int i = 0; i < 4; ++i) { const f32x4 gg = *(const f32x4*)(g1 + i * 256 + lane * 4); v[i] = v[i] * rstd * gg; ss2 += v[i][0] * v[i][0] + v[i][1] * v[i][1] + v[i][2] * v[i][2] + v[i][3] * v[i][3]; }
      if (mode == 2) {
#pragma unroll
        for (int i = 0; i < 4; ++i) *(f32x4*)(H + (size_t)row * DM + i * 256 + lane * 4) = v[i];
        if (g2 == nullptr) continue;
        ss2 = wave_sum(ss2); const float rstd2 = rsqrtf(ss2 * (1.f / DM) + EPS);
#pragma unroll
        for (int i = 0; i < 4; ++i) { const f32x4 gg = *(const f32x4*)(g2 + i * 256 + lane * 4); v[i] = v[i] * rstd2 * gg; }
      }
#pragma unroll
      for (int i = 0; i < 4; ++i) { u32x2 w; w.x = cvt_pk_bf16(v[i][0], v[i][1]); w.y = cvt_pk_bf16(v[i][2], v[i][3]); *(u32x2*)(XN + (size_t)row * DM + i * 256 + lane * 4) = w; }
    }
  }
}
__device__ __forceinline__ void rows_mla_a(const Params& P, int j) {
  bf16_t* C = (bf16_t*)(P.ws + WS_S + S_CQKV); const float* qa = P.m_qa + j * 384; const float* kva = P.m_kva + j * 256;
  const int lane = tidx() & 63, gw = blockIdx.x * 8 + (tidx() >> 6), nw = gridDim.x * 8;
  for (int row = gw; row < T_ALL; row += nw) {
    bf16_t* r = C + (size_t)row * 768;
    unsigned q[3]; float ssq = 0.f;
#pragma unroll
    for (int i = 0; i < 3; ++i) { q[i] = *(const unsigned*)(r + i * 128 + lane * 2); const float a = bflo(q[i]), b = bfhi(q[i]); ssq += a * a + b * b; }
    const u32x2 kk = *(const u32x2*)(r + 384 + lane * 4);
    float kv[4] = {bflo(kk.x), bfhi(kk.x), bflo(kk.y), bfhi(kk.y)};
    float ssk = kv[0] * kv[0] + kv[1] * kv[1] + kv[2] * kv[2] + kv[3] * kv[3];
    ssq = wave_sum(ssq); ssk = wave_sum(ssk);
    const float rq = rsqrtf(ssq * (1.f / 384.f) + EPS), rk = rsqrtf(ssk * (1.f / 256.f) + EPS);
#pragma unroll
    for (int i = 0; i < 3; ++i) { const int c = i * 128 + lane * 2; *(unsigned*)(r + c) = cvt_pk_bf16(bflo(q[i]) * rq * qa[c], bfhi(q[i]) * rq * qa[c + 1]); }
    { const int c = lane * 4; u32x2 w; w.x = cvt_pk_bf16(kv[0] * rk * kva[c], kv[1] * rk * kva[c + 1]); w.y = cvt_pk_bf16(kv[2] * rk * kva[c + 2], kv[3] * rk * kva[c + 3]); *(u32x2*)(r + 384 + c) = w; }
  }
}
__device__ __forceinline__ void rows_mla_b(const Params& P, int j, int grp) {
  bf16_t* Qg = (bf16_t*)(P.ws + WS_S + S_Q); bf16_t* KVg = (bf16_t*)(P.ws + WS_S + S_KV); bf16_t* KPE = (bf16_t*)(P.ws + WS_S + S_KPE);
  const bf16_t* C = (const bf16_t*)(P.ws + WS_S + S_CQKV);
  const float* qn = P.m_qn + j * 192; const float* kn = P.m_kn + j * 192;
  const float* c64 = (const float*)(P.ws + WS_TAB); const float* s64 = c64 + 8192 * 32;
  const int lane = tidx() & 63, gw = blockIdx.x * 8 + (tidx() >> 6), nw = gridDim.x * 8;
  const int hd = lane >> 3, sub = lane & 7; const int seqmask = grp == 0 ? 4095 : 8191;
  for (int t = gw; t < T_GRP; t += nw) {
    const int pos = t & seqmask; const size_t grow = (size_t)grp * T_GRP + t;
    const float* cp = c64 + pos * 32 + (sub & 3) * 8; const float* sp = s64 + pos * 32 + (sub & 3) * 8;
    float cs[8], sn[8];
#pragma unroll
    for (int e = 0; e < 8; ++e) { cs[e] = cp[e]; sn[e] = sp[e]; }
    { bf16_t* qp = Qg + (size_t)t * 1536 + hd * 192 + sub * 8;
      float x[24]; float ss = 0.f;
#pragma unroll
      for (int c = 0; c < 3; ++c) { const u32x4 w = *(const u32x4*)(qp + 64 * c); const unsigned ww[4] = {w.x, w.y, w.z, w.w};
#pragma unroll
        for (int e = 0; e < 4; ++e) { x[c * 8 + 2 * e] = bflo(ww[e]); x[c * 8 + 2 * e + 1] = bfhi(ww[e]); } }
#pragma unroll
      for (int e = 0; e < 24; ++e) ss += x[e] * x[e];
      ss += __shfl_xor(ss, 1); ss += __shfl_xor(ss, 2); ss += __shfl_xor(ss, 4);
      const float rstd = rsqrtf(ss * (1.f / 192.f) + EPS);
#pragma unroll
      for (int c = 0; c < 3; ++c)
#pragma unroll
        for (int e = 0; e < 8; ++e) x[c * 8 + e] *= rstd * qn[c * 64 + sub * 8 + e];
#pragma unroll
      for (int e = 0; e < 8; ++e) { const float own = x[16 + e]; const float oth = __shfl_xor(own, 4);
        x[16 + e] = (sub < 4) ? (own * cs[e] - oth * sn[e]) : (own * cs[e] + oth * sn[e]); }
#pragma unroll
      for (int c = 0; c < 3; ++c) { u32x4 w; w.x = cvt_pk_bf16(x[c * 8], x[c * 8 + 1]); w.y = cvt_pk_bf16(x[c * 8 + 2], x[c * 8 + 3]); w.z = cvt_pk_bf16(x[c * 8 + 4], x[c * 8 + 5]); w.w = cvt_pk_bf16(x[c * 8 + 6], x[c * 8 + 7]);
        *(u32x4*)(qp + 64 * c) = w; }
    }
    { bf16_t* kp = KVg + (size_t)t * 2048 + hd * 256 + sub * 8; const bf16_t* pp = C + grow * 768 + 640 + sub * 8;
      float x[24]; float ss = 0.f;
#pragma unroll
      for (int c = 0; c < 3; ++c) { const u32x4 w = (c < 2) ? *(const u32x4*)(kp + 64 * c) : *(const u32x4*)pp; const unsigned ww[4] = {w.x, w.y, w.z, w.w};
#pragma unroll
        for (int e = 0; e < 4; ++e) { x[c * 8 + 2 * e] = bflo(ww[e]); x[c * 8 + 2 * e + 1] = bfhi(ww[e]); } }
#pragma unroll
      for (int e = 0; e < 24; ++e) ss += x[e] * x[e];
      ss += __shfl_xor(ss, 1); ss += __shfl_xor(ss, 2); ss += __shfl_xor(ss, 4);
      const float rstd = rsqrtf(ss * (1.f / 192.f) + EPS);
#pragma unroll
      for (int c = 0; c < 3; ++c)
#pragma unroll
        for (int e = 0; e < 8; ++e) x[c * 8 + e] *= rstd * kn[c * 64 + sub * 8 + e];
#pragma unroll
      for (int e = 0; e < 8; ++e) { const float own = x[16 + e]; const float oth = __shfl_xor(own, 4);
        x[16 + e] = (sub < 4) ? (own * cs[e] - oth * sn[e]) : (own * cs[e] + oth * sn[e]); }
#pragma unroll
      for (int c = 0; c < 2; ++c) { u32x4 w; w.x = cvt_pk_bf16(x[c * 8], x[c * 8 + 1]); w.y = cvt_pk_bf16(x[c * 8 + 2], x[c * 8 + 3]); w.z = cvt_pk_bf16(x[c * 8 + 4], x[c * 8 + 5]); w.w = cvt_pk_bf16(x[c * 8 + 6], x[c * 8 + 7]);
        *(u32x4*)(kp + 64 * c) = w; }
      { u32x4 w; w.x = cvt_pk_bf16(x[16], x[17]); w.y = cvt_pk_bf16(x[18], x[19]); w.z = cvt_pk_bf16(x[20], x[21]); w.w = cvt_pk_bf16(x[22], x[23]);
        *(u32x4*)(KPE + (size_t)t * 512 + hd * 64 + sub * 8) = w; }
    }
  }
}
__device__ __forceinline__ void rows_ret_gn(const Params& P, int j) {
  bf16_t* Y = (bf16_t*)(P.ws + WS_S + S_RQ); const bf16_t* OF = (const bf16_t*)(P.ws + WS_S + S_OF); const bf16_t* OB = (const bf16_t*)(P.ws + WS_S + S_OB); const bf16_t* RG = (const bf16_t*)(P.ws + WS_S + S_RG);
  const float* gn = P.r_gn + j * 2048;
  const int lane = tidx() & 63, gw = blockIdx.x * 8 + (tidx() >> 6), nw = gridDim.x * 8;
  for (int task = gw; task < T_GRP * 4; task += nw) {
    const size_t off = (size_t)(task >> 2) * 2048 + (task & 3) * 512 + lane * 8;
    const size_t offo = ((size_t)((task & 3) * 16 + (lane >> 2)) * T_GRP + (task >> 2)) * 32 + (lane & 3) * 8;
    const u32x4 a = *(const u32x4*)(OF + offo), b = *(const u32x4*)(OB + offo), g = *(const u32x4*)(RG + off);
    const unsigned aw[4] = {a.x, a.y, a.z, a.w}, bw[4] = {b.x, b.y, b.z, b.w}, gw4[4] = {g.x, g.y, g.z, g.w};
    float o[8]; float sm = 0.f;
#pragma unroll
    for (int e = 0; e < 4; ++e) { o[2 * e] = bflo(aw[e]) + bflo(bw[e]); o[2 * e + 1] = bfhi(aw[e]) + bfhi(bw[e]); sm += o[2 * e] + o[2 * e + 1]; }
    sm = wave_sum(sm); const float mu = sm * (1.f / 512.f);
    float vs = 0.f;
#pragma unroll
    for (int e = 0; e < 8; ++e) { o[e] -= mu; vs += o[e] * o[e]; }
    vs = wave_sum(vs); const float rstd = rsqrtf(vs * (1.f / 512.f) + EPS);
    const float* gp = gn + (task & 3) * 512 + lane * 8;
    float y[8];
#pragma unroll
    for (int e = 0; e < 4; ++e) { y[2 * e] = o[2 * e] * rstd * gp[2 * e] * bflo(gw4[e]); y[2 * e + 1] = o[2 * e + 1] * rstd * gp[2 * e + 1] * bfhi(gw4[e]); }
    u32x4 w; w.x = cvt_pk_bf16(y[0], y[1]); w.y = cvt_pk_bf16(y[2], y[3]); w.z = cvt_pk_bf16(y[4], y[5]); w.w = cvt_pk_bf16(y[6], y[7]);
    *(u32x4*)(Y + off) = w;
  }
}


#define XB_TMO      128
#define XB_XCNT(j)  (256  + 64 * (j))
#define XB_XSUB(j)  (1280 + 64 * (j))
#define XB_XGEN(j)  (2304 + 64 * (j))
#define XB_TOP      3328
#define XB_TOPGEN   3392
#define XCD_BAR_WORDS 3456
#define XB_SPIN_CAP (1u << 22)
__device__ __forceinline__ unsigned xb_ld(unsigned* p)              { return __hip_atomic_load(p, __ATOMIC_RELAXED, __HIP_MEMORY_SCOPE_AGENT); }
__device__ __forceinline__ unsigned xb_add(unsigned* p, unsigned v) { return __hip_atomic_fetch_add(p, v, __ATOMIC_RELAXED, __HIP_MEMORY_SCOPE_AGENT); }
__device__ __forceinline__ unsigned xb_xcc_id() { return (unsigned)__builtin_amdgcn_s_getreg((3 << 11) | 20) & 0xFu; }
#define XB_SPIN(cond, bar) do { unsigned _sp = 0; while (cond) { __builtin_amdgcn_s_sleep(1); \
    if ((++_sp & 255u) == 0u) { if (xb_ld(&(bar)[XB_TMO])) break; if (_sp > XB_SPIN_CAP) { atomicAdd(&(bar)[XB_TMO], 1u); break; } } } } while (0)
__device__ __forceinline__ void xcd_barrier_complete(unsigned* bar, unsigned x, unsigned& nloc, unsigned& nx) {
    const unsigned G = gridDim.x;
    unsigned sum, cnt, mine, sp = 0u;
    for (;;) {
        sum = 0u; cnt = 0u; mine = 0u;
#pragma unroll
        for (unsigned j = 0; j < 16; ++j) { const unsigned c = xb_ld(&bar[XB_XCNT(j)]); sum += c; cnt += (c > 0u) ? 1u : 0u; mine = (j == x) ? c : mine; }
        if (sum == G) break;
        __builtin_amdgcn_s_sleep(1);
        if ((++sp & 255u) == 0u) { if (xb_ld(&bar[XB_TMO])) break; if (sp > XB_SPIN_CAP) { atomicAdd(&bar[XB_TMO], 1u); break; } }
    }
    nloc = mine > 0u ? mine : 1u; nx = cnt > 0u ? cnt : 1u;
}
__device__ __forceinline__ void xcd_barrier(unsigned* bar, unsigned x, volatile LAS unsigned* st) {
    asm volatile("s_waitcnt vmcnt(0)" ::: "memory");
    __syncthreads();
    if (threadIdx.x == 0) {
        __builtin_amdgcn_s_waitcnt(0);
        unsigned nloc = st[0], nx = st[1];
        if (nloc == 0u) { xcd_barrier_complete(bar, x, nloc, nx); st[0] = nloc; st[1] = nx; }
        const unsigned old = xb_add(&bar[XB_XSUB(x)], 1u);
        const unsigned gen = old / nloc;
        if (old + 1u == (gen + 1u) * nloc) {
            __builtin_amdgcn_fence(__ATOMIC_RELEASE, "agent");
            asm volatile("s_waitcnt vmcnt(0)" ::: "memory");
            const unsigned og = xb_add(&bar[XB_TOP], 1u);
            const unsigned tg = og / nx;
            if (og + 1u == (tg + 1u) * nx) xb_add(&bar[XB_TOPGEN], 1u);
            else XB_SPIN(xb_ld(&bar[XB_TOPGEN]) == tg, bar);
            __builtin_amdgcn_fence(__ATOMIC_ACQUIRE, "agent");
            xb_add(&bar[XB_XGEN(x)], 1u);
            asm volatile("s_waitcnt vmcnt(0)" ::: "memory");
        } else {
            XB_SPIN(xb_ld(&bar[XB_XGEN(x)]) == gen, bar);
            __builtin_amdgcn_fence(__ATOMIC_ACQUIRE, "agent");
            asm volatile("s_waitcnt vmcnt(0)" ::: "memory");
        }
    }
    __syncthreads();
}
#define GRID_BARRIER(wsptr) xcd_barrier((unsigned*)((wsptr) + WS_BAR), xcc_id, (volatile LAS unsigned*)(L + LDS_BYTES - 64))
constexpr int PH_PER_LAYER = 19, N_PHASES = 1 + 4 * PH_PER_LAYER;
__global__ void __launch_bounds__(512, 2) mega(Params Pk) {
  extern __shared__ __attribute__((aligned(16))) unsigned char lds_raw[];
  cg::grid_group grid = cg::this_grid();
  LAS unsigned char* L = (LAS unsigned char*)lds_raw;
  const int G = gridDim.x;
  const int ph_lo = Pk.ph_lo, ph_hi = Pk.ph_hi;
  if (ph_lo < 0) grid.sync();
  const unsigned xcc_id = xb_xcc_id();
  if (threadIdx.x < 16) ((volatile LAS unsigned*)(L + LDS_BYTES - 64))[threadIdx.x] = 0u;
  if (threadIdx.x == 0) (void)xb_add(&((unsigned*)(Pk.ws + WS_BAR))[XB_XCNT(xcc_id)], 1u);
  __syncthreads();
#pragma unroll 1
  for (int ph = ph_lo; ph < ph_hi; ++ph) {
#if defined(__HIP_DEVICE_COMPILE__)
    const __attribute__((address_space(4))) Params* pp = (const __attribute__((address_space(4))) Params*)__builtin_amdgcn_kernarg_segment_ptr();
    asm volatile("" : "+s"(pp));
    const Params P = *pp;
#else
    const Params P = Pk;
#endif
    bf16_t* Wb = (bf16_t*)(P.ws + WS_W); bf16_t* XN = (bf16_t*)(P.ws + WS_XN); unsigned char* SB = P.ws + WS_S;
    float* H = P.out;
    if (ph == 0) {
      prep_layer((float*)lds_raw, P, 0); build_tables(P); rows_norm(0, P, P.norm_g, nullptr);
    } else {
      const int layer = (ph - 1) / PH_PER_LAYER, p = (ph - 1) % PH_PER_LAYER, j = layer >> 1; const bool is_ret = layer & 1;
      const float* ng = P.norm_g + layer * 4 * DM;
      int op = 0, grp = 0, s = 0;
      if (p == 0 || p == 16) { op = 0; s = (p == 16); }
      else if (p == 1 || p == 17) { op = 1; s = (p == 17); }
      else if (p == 2 || p == 15) op = 2;
      else if (p == 18) op = 3;
      else if (!is_ret) {
        if (p == 3) op = 4; else if (p == 4) op = 5; else if (p == 14) op = 1;
        else { grp = (p - 5) / 3; const int sub = (p - 5) % 3; op = sub == 0 ? 4 : (sub == 1 ? 6 : 7); }
      } else { grp = (p - 3) / 4; const int sub = (p - 3) % 4; op = sub == 0 ? 8 : (sub == 1 ? 9 : (sub == 2 ? 10 : 1)); }
      const int seqlen = grp == 0 ? 4096 : 8192, nseq = grp == 0 ? 4 : 2;

      if (op == 0) {
        pg8::Gemm g{XN, Wb + (s ? WE_GU1 : WE_GU0), T_ALL, 2 * FF, DM, DM}; pg8::StaticOrder S; S.init(T_ALL, 2 * FF, G, blockIdx.x);
        pg8::EpiSwiGLU E{(bf16_t*)(SB + S_ACT)};
#ifndef REP_FFNUP
#define REP_FFNUP 1
#endif
#pragma unroll 1
        for (int rep = 0; rep < REP_FFNUP; ++rep) pg8::gemm_phase(L, g, S, E);
      } else if (op == 1) {
        pg8::Gemm g; float* Hh = H; float alpha = 0.5f;
        if (p == 1 || p == 17) g = pg8::Gemm{(const bf16_t*)(SB + S_ACT), Wb + (s ? WE_D1 : WE_D0), T_ALL, DM, FF, FF};
        else if (!is_ret) { g = pg8::Gemm{XN, Wb + WE_MO, T_ALL, DM, DM, DM}; alpha = 1.f; }
        else { g = pg8::Gemm{(const bf16_t*)(SB + S_RQ), Wb + WE_RO, T_GRP, DM, 2048, 2048}; alpha = 1.f; Hh = H + (size_t)grp * T_GRP * DM; }
        pg8::StaticOrder S; S.init(g.M, DM, G, blockIdx.x);
        pg8::EpiResid E{Hh, alpha}; pg8::gemm_phase(L, g, S, E);
      } else if (op == 2) {
#ifndef REP_NORM
#define REP_NORM 1
#endif
        for (int rn_ = 0; rn_ < REP_NORM; ++rn_) rows_norm(1, P, ng + (p == 2 ? 1 : 2) * DM, nullptr);
      } else if (op == 3) {
        if (layer < 3) prep_layer((float*)lds_raw, P, layer + 1);
        rows_norm(2, P, ng + 3 * DM, layer < 3 ? ng + 4 * DM : nullptr);
      } else if (op == 4) {
        const int ng2 = (p == 3) ? 1 : 2;
#pragma unroll 1
#ifndef REP_BF16
#define REP_BF16 1
#endif
        for (int gi = 0; gi < ng2 * REP_BF16; ++gi) {
          pg8::Gemm g; pg8::EpiBf16 E;
          if (p == 3) { g = pg8::Gemm{XN, Wb + WE_DQKV, T_ALL, 768, DM, DM}; E = pg8::EpiBf16{(bf16_t*)(SB + S_CQKV), 768}; }
          else if ((gi & 1) == 0) { g = pg8::Gemm{(const bf16_t*)(SB + S_CQKV) + (size_t)grp * T_GRP * 768, Wb + WE_UQ, T_GRP, 1536, 384, 768}; E = pg8::EpiBf16{(bf16_t*)(SB + S_Q), 1536}; }
          else { g = pg8::Gemm{(const bf16_t*)(SB + S_CQKV) + (size_t)grp * T_GRP * 768 + 384, Wb + WE_UKV, T_GRP, 2048, 256, 768}; E = pg8::EpiBf16{(bf16_t*)(SB + S_KV), 2048}; }
          pg8::StaticOrder S; S.init(g.M, g.N, G, blockIdx.x);
          pg8::gemm_phase(L, g, S, E);
        }
      } else if (op == 5) {
        rows_mla_a(P, j);
      } else if (op == 6) {
        rows_mla_b(P, j, grp);
      } else if (op == 7) {
        const int nqb = seqlen >> 8; const int nunits = nseq * 8 * nqb;
        const bf16_t* Qg = (const bf16_t*)(SB + S_Q); const bf16_t* KVg = (const bf16_t*)(SB + S_KV); const bf16_t* KPE = (const bf16_t*)(SB + S_KPE);
#ifndef REP_ATTN
#define REP_ATTN 1
#endif
#pragma unroll 1
        for (int rep = 0; rep < REP_ATTN; ++rep)
#pragma unroll 1
        for (int u = blockIdx.x; u < nunits; u += G) {
          int qb = u % nqb, pr = u / nqb;
          if (G == 256) {
            const int rnd = u >> 8, bb = u & 255, xx = bb & 7, vb = bb >> 3;
            if (nqb == 32) { pr = rnd * 8 + xx; qb = vb; } else { pr = rnd * 16 + xx * 2 + (vb >> 4); qb = vb & 15; }
          }
          const int hd = pr & 7, sq = pr >> 3;
          const size_t r0 = (size_t)sq * seqlen;
          att::attn_unit(Qg + (r0 + (size_t)qb * 256) * 1536 + hd * 192, KVg + r0 * 2048 + hd * 256, KPE + r0 * 512 + hd * 64,
                         XN + ((size_t)grp * T_GRP + r0 + (size_t)qb * 256) * DM + hd * 128, seqlen, (char*)lds_raw, (int)(uintptr_t)L);
        }
      } else if (op == 8) {
        const float* c256 = (const float*)(P.ws + WS_TAB) + 2 * 8192 * 32;
        pg8::Gemm g{XN + (size_t)grp * T_GRP * DM, Wb + WE_RIN, T_GRP, 6144, DM, DM}; pg8::StaticOrder S; S.init(T_GRP, 6144, G, blockIdx.x);
        pg8::EpiRet E{(bf16_t*)(SB + S_RQ), (bf16_t*)(SB + S_RK), (bf16_t*)(SB + S_RKT), (bf16_t*)(SB + S_RV), (bf16_t*)(SB + S_RG), c256, c256 + 8192 * 128, seqlen - 1};
#ifndef REP_RETPROJ
#define REP_RETPROJ 1
#endif
#pragma unroll 1
        for (int rep = 0; rep < REP_RETPROJ; ++rep) pg8::gemm_phase(L, g, S, E);
      } else if (op == 9) {
        bf16_t* Pg = (bf16_t*)(P.ws + WS_P);
#define LG2_OF(dec_) ({ const float xg_ = __builtin_amdgcn_exp2f((dec_) * 1.4426950408889634f); \
          const float ser_ = xg_ * (1.f + xg_ * (0.5f + xg_ * (0.33333334f + xg_ * (0.25f + xg_ * (0.2f + xg_ * (0.16666667f + xg_ * (0.14285715f + xg_ * 0.125f))))))); -ser_ * 1.4426950408889634f; })
#pragma unroll 1
        for (int u = blockIdx.x; u < (T_GRP / 64) * 4; u += G) {
          const int hd = u & 3, c = u >> 2;
          ret::p_unit(L, (const bf16_t*)(SB + S_RQ), (const bf16_t*)(SB + S_RK), Pg, c, hd, LG2_OF(P.r_df[j * 4 + hd]), LG2_OF(P.r_db[j * 4 + hd]));
        }
        GRID_BARRIER(P.ws);
        const int nitems = nseq * 4 * 2 * 16;
#ifndef REP_SCAN
#define REP_SCAN 1
#endif
#pragma unroll 1
        for (int rep = 0; rep < REP_SCAN; ++rep)
#pragma unroll 1
        for (int itx = blockIdx.x; itx < nitems; itx += G) {
          int sl = itx & 15, combo = itx >> 4;
          if (G == 256) {
            const int rnd = itx >> 8, bb = itx & 255, xx = bb & 7, vb = bb >> 3;
            sl = vb & 15; combo = rnd * 16 + xx * 2 + (vb >> 4);
          }
          const int dir = combo & 1, hd = (combo >> 1) & 3, sq = combo >> 3;
          const float lg2 = LG2_OF((dir ? P.r_db : P.r_df)[j * 4 + hd]);
          ret::scan_item(L, (const bf16_t*)(SB + S_RQ), (const bf16_t*)(SB + S_RKT), (const bf16_t*)(SB + S_RV), Pg,
                         (bf16_t*)(SB + (dir ? S_OB : S_OF)), seqlen, sq, hd, dir, sl, lg2);
        }
      } else if (op == 10) {
        rows_ret_gn(P, j);
      }
    }
#ifndef REP_BAR
#define REP_BAR 1
#endif
    if (ph + 1 < ph_hi) { for (int rb_ = 0; rb_ < REP_BAR; ++rb_) GRID_BARRIER(P.ws); }
  }
#ifdef DBG_N
  {
    unsigned char* wsb = Pk.ws; float* Hh = Pk.out; const unsigned* XNw = (const unsigned*)(wsb + WS_XN);
    GRID_BARRIER(wsb);
    unsigned hsh = 0, nanc = 0; const size_t nth = (size_t)G * 512, gt = (size_t)blockIdx.x * 512 + threadIdx.x;
#if DBG_WHAT & 1
    for (size_t i = gt; i < (size_t)T_ALL * DM; i += nth) { const unsigned u = __float_as_uint(Hh[i]); hsh += u * 2654435761u + 1u; if ((u & 0x7f800000u) == 0x7f800000u) ++nanc; }
#endif
#if DBG_WHAT & 2
    for (size_t i = gt; i < (size_t)T_ALL * DM / 2; i += nth) { const unsigned u = XNw[i]; hsh += u * 2246822519u + 1u; if ((u & 0x7f800000u) == 0x7f800000u || (u & 0x7f80u) == 0x7f80u) ++nanc; }
#endif
#if DBG_WHAT & 4
    { const unsigned* Sw = (const unsigned*)(wsb + WS_S + DBG_OFF); for (size_t i = gt; i < (size_t)DBG_LEN / 4; i += nth) { const unsigned u = Sw[i]; hsh += u * 3266489917u + 1u; if ((u & 0x7f800000u) == 0x7f800000u || (u & 0x7f80u) == 0x7f80u) ++nanc; } }
#endif
    unsigned* cnt = (unsigned*)(wsb + WS_BAR) + 3520;
    atomicAdd(cnt, hsh); atomicAdd(cnt + 1, nanc);
    GRID_BARRIER(wsb);
    const unsigned th = __hip_atomic_load(cnt, __ATOMIC_RELAXED, __HIP_MEMORY_SCOPE_AGENT), tn = __hip_atomic_load(cnt + 1, __ATOMIC_RELAXED, __HIP_MEMORY_SCOPE_AGENT);
    const float v = (tn ? 30.f : 10.f) + (float)(th & 1023u) * 1e-3f;
    for (size_t i = gt; i < (size_t)T_ALL * DM; i += nth) Hh[i] = v;
  }
#endif
}

extern "C" void kernel_launch(void* const* d_in, const int* in_sizes, int n_in, void* d_out, int out_size, void* d_ws, size_t ws_size, hipStream_t stream) {
  static int grid_blocks = 0;
  if (grid_blocks == 0) {
    if (n_in != 20 || out_size != T_ALL * DM || ws_size < WS_END) { fprintf(stderr, "kernel_launch: unexpected shapes n_in %d out %d ws %zu (need %zu)\n", n_in, out_size, ws_size, (size_t)WS_END); }
    int dev = 0, cus = 0, per_cu = 0;
    (void)hipGetDevice(&dev);
    (void)hipDeviceGetAttribute(&cus, hipDeviceAttributeMultiprocessorCount, dev);
    if (hipFuncSetAttribute((const void*)mega, hipFuncAttributeMaxDynamicSharedMemorySize, LDS_BYTES) != hipSuccess) fprintf(stderr, "kernel_launch: hipFuncSetAttribute failed\n");
    if (hipOccupancyMaxActiveBlocksPerMultiprocessor(&per_cu, (const void*)mega, 512, LDS_BYTES) != hipSuccess || per_cu < 1) { fprintf(stderr, "kernel_launch: occupancy query gave %d\n", per_cu); per_cu = 1; }
    (void)hipGetLastError();
    grid_blocks = cus * per_cu;
  }
  Params p{};
  p.xp = (const float*)d_in[0]; p.xs = (const float*)d_in[1]; p.norm_g = (const float*)d_in[2]; p.ffn_g = (const float*)d_in[3]; p.ffn_u = (const float*)d_in[4]; p.ffn_d = (const float*)d_in[5];
  p.m_dq = (const float*)d_in[6]; p.m_qa = (const float*)d_in[7]; p.m_uq = (const float*)d_in[8]; p.m_dkv = (const float*)d_in[9]; p.m_kva = (const float*)d_in[10]; p.m_ukv = (const float*)d_in[11];
  p.m_qn = (const float*)d_in[12]; p.m_kn = (const float*)d_in[13]; p.m_wo = (const float*)d_in[14];
  p.r_in = (const float*)d_in[15]; p.r_df = (const float*)d_in[16]; p.r_db = (const float*)d_in[17]; p.r_gn = (const float*)d_in[18]; p.r_wo = (const float*)d_in[19];
  p.out = (float*)d_out; p.ws = (unsigned char*)d_ws; p.ph_lo = 0; p.ph_hi = N_PHASES;
#ifdef DBG_N
  p.ph_hi = DBG_N;
#endif
  (void)hipMemsetAsync((char*)d_ws + WS_BAR, 0, 16384, stream);
  void* args[] = {&p};
  hipError_t e = hipLaunchCooperativeKernel((const void*)mega, dim3(grid_blocks), dim3(512), args, LDS_BYTES, stream);
  if (e != hipSuccess) fprintf(stderr, "kernel_launch: cooperative launch failed: %s (grid %d)\n", hipGetErrorString(e), grid_blocks);
}
```

```cpp
#include <hip/hip_runtime.h>
#include <hip/hip_cooperative_groups.h>
#include <cstdio>
#include <cstdint>
#include <cmath>
namespace cg = cooperative_groups;

#define LAS __attribute__((address_space(3)))
typedef unsigned short bf16_t;
typedef short bf16x8 __attribute__((ext_vector_type(8)));
typedef short s16x4 __attribute__((ext_vector_type(4)));
typedef float f32x4 __attribute__((ext_vector_type(4)));
typedef float f32x16 __attribute__((ext_vector_type(16)));
typedef unsigned u32x4 __attribute__((ext_vector_type(4)));
typedef unsigned u32x2 __attribute__((ext_vector_type(2)));

constexpr int T_ALL = 49152, T_GRP = 16384, DM = 1024, FF = 2816;
constexpr float EPS = 1e-6f;
constexpr int LDS_BYTES = 147456;
constexpr size_t MiB = 1u << 20;
constexpr size_t WS_W = 0;
constexpr size_t WS_TAB = 56 * MiB;
constexpr size_t WS_XN = 66 * MiB;
constexpr size_t WS_S = 162 * MiB;
constexpr size_t WS_BAR = WS_S + 352 * MiB;
constexpr size_t WS_P = WS_BAR + 16384;
constexpr size_t WS_END = WS_P + 16 * MiB;
constexpr size_t WE_GU0 = 0, WE_D0 = WE_GU0 + (size_t)5632 * 1024, WE_GU1 = WE_D0 + (size_t)1024 * 2816, WE_D1 = WE_GU1 + (size_t)5632 * 1024,
                 WE_MIX = WE_D1 + (size_t)1024 * 2816;
constexpr size_t WE_DQKV = WE_MIX, WE_UQ = WE_DQKV + (size_t)768 * 1024, WE_UKV = WE_UQ + (size_t)1536 * 384, WE_MO = WE_UKV + (size_t)2048 * 256;
constexpr size_t WE_RIN = WE_MIX, WE_RO = WE_RIN + (size_t)6144 * 1024;
constexpr size_t S_ACT = 0;
constexpr size_t S_CQKV = 0, S_Q = 72 * MiB, S_KV = 120 * MiB, S_KPE = 184 * MiB;
constexpr size_t S_RQ = 0, S_RK = 32 * MiB, S_RKT = 64 * MiB, S_RV = 96 * MiB, S_RG = 160 * MiB, S_OF = 224 * MiB, S_OB = 288 * MiB;

struct Params {
  const float* xp; const float* xs; const float* norm_g; const float* ffn_g; const float* ffn_u; const float* ffn_d;
  const float* m_dq; const float* m_qa; const float* m_uq; const float* m_dkv; const float* m_kva; const float* m_ukv;
  const float* m_qn; const float* m_kn; const float* m_wo;
  const float* r_in; const float* r_df; const float* r_db; const float* r_gn; const float* r_wo;
  float* out; unsigned char* ws;
  int ph_lo, ph_hi;
};

typedef __bf16 bf16x2_t __attribute__((ext_vector_type(2)));
typedef float f32x2_t __attribute__((ext_vector_type(2)));
__device__ __forceinline__ unsigned cvt_pk_bf16(float lo, float hi) { const f32x2_t v = {lo, hi}; const bf16x2_t b = __builtin_convertvector(v, bf16x2_t); return __builtin_bit_cast(unsigned, b); }
__device__ __forceinline__ float bflo(unsigned w) { return __uint_as_float(w << 16); }
__device__ __forceinline__ float bfhi(unsigned w) { return __uint_as_float(w & 0xffff0000u); }
__device__ __forceinline__ float bf2f(unsigned short u) { return __uint_as_float(((unsigned)u) << 16); }
__device__ __forceinline__ unsigned short f2bf(float f) { return (unsigned short)(cvt_pk_bf16(f, 0.f) & 0xffffu); }
__device__ __forceinline__ float wave_sum(float v) {
#pragma unroll
  for (int o = 32; o > 0; o >>= 1) v += __shfl_xor(v, o);
  return v;
}
__device__ __forceinline__ int tidx() { int t = threadIdx.x; asm volatile("" : "+v"(t)); return t; }
__device__ __forceinline__ float silu_f(float x) { return x * __builtin_amdgcn_rcpf(1.f + __builtin_amdgcn_exp2f(-1.4426950408889634f * x)); }

namespace pg8 {
constexpr int BM = 256, BK = 64, HALF = 128, HTB = HALF * BK * 2, NXCD = 8, WGM = 8;
__host__ __device__ __forceinline__ int lds_byte(int r, int c) { const int st = (r >> 4) * 2 + (c >> 5), rr = r & 15, cc = c & 31, ob = rr * 64 + cc * 2; return st * 1024 + (ob ^ (((ob >> 9) & 1) << 5)); }
__host__ __device__ __forceinline__ void stage_rc(int b, int& R, int& C) { const int st = b / 1024, sb = b % 1024, swz = sb ^ (((sb >> 9) & 1) << 5); R = (st >> 1) * 16 + swz / 64; C = (st & 1) * 32 + (swz % 64) / 2; }
__host__ __device__ __forceinline__ int perm32(int rho) { const int n = rho >> 4, i = rho & 15; return 8 * (i >> 2) + 4 * n + (i & 3); }
struct Unit { int pm, pn; };
struct Gemm { const bf16_t* A; const bf16_t* Bt; int M, N, K, lda; };
struct StaticOrder {
  int nM, nN, nwg, G, c;
  __device__ void init(int M, int N, int G_, int c_) { nM = M / BM; nN = N / BM; nwg = nM * nN; G = G_; c = c_; }
  __device__ bool next(int i, Unit& u) const {
    const long L = (long)i * G + c; if (L >= nwg) return false;
    int wgid = (int)L; { const int q = nwg / NXCD, r = nwg % NXCD, xcd = wgid % NXCD, off = wgid / NXCD; wgid = (xcd < r ? xcd * (q + 1) : r * (q + 1) + (xcd - r) * q) + off; }
    const int nig = WGM * nN, gid = wgid / nig, fm = gid * WGM, gsz = (nM - fm) < WGM ? (nM - fm) : WGM;
    u.pm = fm + ((wgid % nig) % gsz); u.pn = (wgid % nig) / gsz; return true;
  }
};
template <class Epi>
__device__ __forceinline__ void gemm_phase(LAS unsigned char* lds, const Gemm g, const StaticOrder& S, const Epi& E) {
  const int tid = tidx(), wid = __builtin_amdgcn_readfirstlane(tid >> 6), lane = tid & 63, wr = wid >> 2, wc = wid & 3, fr = lane & 15, fq = lane >> 4;
  const int K = g.K, nt = K / BK, lda = g.lda;
  unsigned voffA[2], voffB[2];
#pragma unroll
  for (int i = 0; i < 2; ++i) { int R, C; stage_rc(tid * 16 + i * 8192, R, C); const int Rb = (R & ~31) + perm32(R & 31);
    voffA[i] = (unsigned)(R * lda + C) * 2u; voffB[i] = (unsigned)(Rb * K + C) * 2u; }
  const size_t kstep = (size_t)(BK * 2);
  const size_t hstepA = (size_t)HALF * lda * 2, hstepB = (size_t)HALF * K * 2;
  const size_t tstepA = 2 * hstepA, tstepB = 2 * hstepB;
  const unsigned ldsw = (unsigned)wid * 1024u;
  const int aoff = lds_byte(wr * 64 + fr, fq * 8), boff = lds_byte(wc * 32 + fr, fq * 8);
#define PG8_SA(b, h) (((b) * 2 + (h)) * HTB)
#define PG8_SB(b, h) ((4 + (b) * 2 + (h)) * HTB)
#define PG8_STAGE(bufoff, gbase, voff) do { _Pragma("unroll") for (int _i = 0; _i < 2; ++_i) \
    __builtin_amdgcn_global_load_lds((const unsigned*)((const char*)(gbase) + (voff)[_i]), (LAS unsigned*)(lds + (bufoff) + ldsw + _i * 8192), 16, 0, 0); } while (0)
#define PG8_LDA(dst, b, h) do { _Pragma("unroll") for (int m = 0; m < 4; ++m) _Pragma("unroll") for (int k = 0; k < 2; ++k) dst[m][k] = *(const LAS bf16x8*)(lds + PG8_SA(b, h) + aoff + m * 2048 + k * 1024); } while (0)
#define PG8_LDB(dst, b, h) do { _Pragma("unroll") for (int n = 0; n < 2; ++n) _Pragma("unroll") for (int k = 0; k < 2; ++k) dst[n][k] = *(const LAS bf16x8*)(lds + PG8_SB(b, h) + boff + n * 2048 + k * 1024); } while (0)
#define PG8_MMA(ai, bj, At, Bt) do { __builtin_amdgcn_s_setprio(1); _Pragma("unroll") for (int m = 0; m < 4; ++m) _Pragma("unroll") for (int n = 0; n < 2; ++n) _Pragma("unroll") for (int k = 0; k < 2; ++k) \
    acc[ai][bj][m][n] = __builtin_amdgcn_mfma_f32_16x16x32_bf16(Bt[n][k], At[m][k], acc[ai][bj][m][n], 0, 0, 0); __builtin_amdgcn_s_setprio(0); } while (0)
#define PG8_WAIT_V(n) asm volatile("s_waitcnt vmcnt(" #n ")" ::: "memory")
#define PG8_WAIT_L(n) asm volatile("s_waitcnt lgkmcnt(" #n ")" ::: "memory")
#define PG8_BAR __builtin_amdgcn_s_barrier()
#define PG8_SCHED __builtin_amdgcn_sched_barrier(0)
  Unit cur, nxt; int ui = 0;
  if (!S.next(0, cur)) return;
  f32x4 acc[2][2][4][2];
#pragma unroll
  for (int a = 0; a < 2; ++a)
#pragma unroll
    for (int b = 0; b < 2; ++b)
#pragma unroll
      for (int m = 0; m < 4; ++m)
#pragma unroll
        for (int n = 0; n < 2; ++n) acc[a][b][m][n] = (f32x4){0.f, 0.f, 0.f, 0.f};
  bf16x8 At[4][2], B0[2][2], B1[2][2];
  const char* cA = (const char*)g.A + (size_t)cur.pm * tstepA; const char* cB = (const char*)g.Bt + (size_t)cur.pn * tstepB;
  PG8_STAGE(PG8_SB(0, 0), cB, voffB); PG8_STAGE(PG8_SB(0, 1), cB + hstepB, voffB); PG8_STAGE(PG8_SA(0, 0), cA, voffA); PG8_STAGE(PG8_SA(0, 1), cA + hstepA, voffA);
  if (wr == 1) PG8_BAR;
  PG8_WAIT_V(2); PG8_BAR;
  PG8_STAGE(PG8_SB(1, 0), cB + kstep, voffB); PG8_STAGE(PG8_SA(1, 0), cA + kstep, voffA); PG8_STAGE(PG8_SB(1, 1), cB + hstepB + kstep, voffB);
  PG8_WAIT_V(6); PG8_BAR;
  for (;;) {
    const bool has_next = S.next(ui + 1, nxt);
    const char* nA = has_next ? (const char*)g.A + (size_t)nxt.pm * tstepA : cA; const char* nB = has_next ? (const char*)g.Bt + (size_t)nxt.pn * tstepB : cB;
    for (int t = 0; t < nt; t += 2) {
      const bool last = (t == nt - 2);
      const char* a1 = cA + (size_t)(t + 1) * kstep;
      const char* a2 = last ? nA : cA + (size_t)(t + 2) * kstep; const char* b2 = last ? nB : cB + (size_t)(t + 2) * kstep;
      const char* a3 = a2 + kstep; const char* b3 = b2 + kstep;
      PG8_LDB(B0, 0, 0); PG8_LDB(B1, 0, 1); PG8_SCHED; PG8_LDA(At, 0, 0); PG8_STAGE(PG8_SA(1, 1), a1 + hstepA, voffA);
      PG8_WAIT_V(8); PG8_WAIT_L(0); PG8_BAR; PG8_MMA(0, 0, At, B0); PG8_MMA(0, 1, At, B1); PG8_BAR; PG8_SCHED;
      PG8_LDA(At, 0, 1); PG8_STAGE(PG8_SB(0, 0), b2, voffB); PG8_STAGE(PG8_SB(0, 1), b2 + hstepB, voffB); PG8_STAGE(PG8_SA(0, 0), a2, voffA);
      PG8_WAIT_V(8); PG8_WAIT_L(0); PG8_BAR; PG8_MMA(1, 0, At, B0); PG8_MMA(1, 1, At, B1); PG8_BAR; PG8_SCHED;
      PG8_LDB(B0, 1, 0); PG8_LDB(B1, 1, 1); PG8_SCHED; PG8_LDA(At, 1, 0); PG8_STAGE(PG8_SA(0, 1), a2 + hstepA, voffA);
      PG8_WAIT_V(8); PG8_WAIT_L(0); PG8_BAR; PG8_MMA(0, 0, At, B0); PG8_MMA(0, 1, At, B1); PG8_BAR; PG8_SCHED;
      PG8_LDA(At, 1, 1); PG8_STAGE(PG8_SB(1, 0), b3, voffB); PG8_STAGE(PG8_SB(1, 1), b3 + hstepB, voffB); PG8_STAGE(PG8_SA(1, 0), a3, voffA);
      PG8_WAIT_V(8); PG8_WAIT_L(0); PG8_BAR; PG8_MMA(1, 0, At, B0); PG8_MMA(1, 1, At, B1); PG8_BAR; PG8_SCHED;
    }
    if (wr == 0) PG8_BAR;
    E(acc, cur, wr, wc, fr, fq);
    if (!has_next) break;
#pragma unroll
    for (int a = 0; a < 2; ++a)
#pragma unroll
      for (int b = 0; b < 2; ++b)
#pragma unroll
        for (int m = 0; m < 4; ++m)
#pragma unroll
          for (int n = 0; n < 2; ++n) acc[a][b][m][n] = (f32x4){0.f, 0.f, 0.f, 0.f};
    cur = nxt; cA = nA; cB = nB; ++ui;
    if (wr == 1) PG8_BAR;
  }
  PG8_WAIT_V(0);
  PG8_BAR;
#undef PG8_SA
#undef PG8_SB
#undef PG8_STAGE
#undef PG8_LDA
#undef PG8_LDB
#undef PG8_MMA
#undef PG8_WAIT_V
#undef PG8_WAIT_L
#undef PG8_BAR
#undef PG8_SCHED
}

struct EpiBf16 {
  bf16_t* O; int ldc;
  __device__ __forceinline__ void operator()(const f32x4 (&acc)[2][2][4][2], const Unit& u, int wr, int wc, int fr, int fq) const {
    const int row0 = u.pm * BM + wr * 64 + fr, col0 = u.pn * BM + wc * 32 + 8 * fq;
#pragma unroll
    for (int ai = 0; ai < 2; ++ai)
#pragma unroll
      for (int m = 0; m < 4; ++m) { bf16_t* rowp = O + (size_t)(row0 + ai * HALF + m * 16) * ldc + col0;
#pragma unroll
        for (int bj = 0; bj < 2; ++bj) { const f32x4 v0 = acc[ai][bj][m][0], v1 = acc[ai][bj][m][1];
          u32x4 w; w.x = cvt_pk_bf16(v0[0], v0[1]); w.y = cvt_pk_bf16(v0[2], v0[3]); w.z = cvt_pk_bf16(v1[0], v1[1]); w.w = cvt_pk_bf16(v1[2], v1[3]);
          *(u32x4*)(rowp + bj * HALF) = w; } }
  }
};
struct EpiSwiGLU {
  bf16_t* O;
  __device__ __forceinline__ void operator()(const f32x4 (&acc)[2][2][4][2], const Unit& u, int wr, int wc, int fr, int fq) const {
    const int row0 = u.pm * BM + wr * 64 + fr, col0 = u.pn * 128 + wc * 32 + 8 * fq;
#pragma unroll
    for (int ai = 0; ai < 2; ++ai)
#pragma unroll
      for (int m = 0; m < 4; ++m) { bf16_t* rowp = O + (size_t)(row0 + ai * HALF + m * 16) * FF + col0;
        const f32x4 g0 = acc[ai][0][m][0], g1 = acc[ai][0][m][1], u0 = acc[ai][1][m][0], u1 = acc[ai][1][m][1];
        u32x4 w; w.x = cvt_pk_bf16(silu_f(g0[0]) * u0[0], silu_f(g0[1]) * u0[1]); w.y = cvt_pk_bf16(silu_f(g0[2]) * u0[2], silu_f(g0[3]) * u0[3]);
        w.z = cvt_pk_bf16(silu_f(g1[0]) * u1[0], silu_f(g1[1]) * u1[1]); w.w = cvt_pk_bf16(silu_f(g1[2]) * u1[2], silu_f(g1[3]) * u1[3]);
        *(u32x4*)rowp = w; }
  }
};
struct EpiResid {
  bf16_t* H; float alpha;
  __device__ __forceinline__ void operator()(const f32x4 (&acc)[2][2][4][2], const Unit& u, int wr, int wc, int fr, int fq) const {
    const int row0 = u.pm * BM + wr * 64 + fr, col0 = u.pn * BM + wc * 32 + 8 * fq;
#pragma unroll
    for (int ai = 0; ai < 2; ++ai)
#pragma unroll
      for (int m = 0; m < 4; ++m) { bf16_t* rowp = H + (size_t)(row0 + ai * HALF + m * 16) * DM + col0;
#pragma unroll
        for (int bj = 0; bj < 2; ++bj) { u32x4* p = (u32x4*)(rowp + bj * HALF); const u32x4 h = *p;
          const f32x4 a = acc[ai][bj][m][0] * alpha, b = acc[ai][bj][m][1] * alpha;
          u32x4 w; w.x = cvt_pk_bf16(bflo(h.x) + a[0], bfhi(h.x) + a[1]); w.y = cvt_pk_bf16(bflo(h.y) + a[2], bfhi(h.y) + a[3]);
          w.z = cvt_pk_bf16(bflo(h.z) + b[0], bfhi(h.z) + b[1]); w.w = cvt_pk_bf16(bflo(h.w) + b[2], bfhi(h.w) + b[3]);
          *p = w; } }
  }
};
struct EpiRet {
  bf16_t* RQ; bf16_t* RK; bf16_t* RKT; bf16_t* RV; bf16_t* RG; const float* ctab; const float* stab; int seqmask;
  __device__ __forceinline__ void operator()(const f32x4 (&acc)[2][2][4][2], const Unit& u, int wr, int wc, int fr, int fq) const {
    const int row0 = u.pm * BM + wr * 64 + fr; const int pn = u.pn; const int cin = wc * 32 + 8 * fq;
    if (pn < 8) {
      const bool isk = pn >= 4; const int head = pn & 3; const float sc = isk ? 0.0625f : 1.f;
      bf16_t* dst = isk ? RK : RQ;
#pragma unroll
      for (int ai = 0; ai < 2; ++ai)
#pragma unroll
        for (int m = 0; m < 4; ++m) { const int lr = row0 + ai * HALF + m * 16; const int pos = lr & seqmask;
          const float* cp = ctab + (size_t)pos * 128 + cin; const float* sp = stab + (size_t)pos * 128 + cin;
          float o1[8], o2[8];
#pragma unroll
          for (int n = 0; n < 2; ++n) { const f32x4 c4 = *(const f32x4*)(cp + 4 * n), s4 = *(const f32x4*)(sp + 4 * n); const f32x4 x1 = acc[ai][0][m][n], x2 = acc[ai][1][m][n];
#pragma unroll
            for (int j = 0; j < 4; ++j) { o1[4 * n + j] = (x1[j] * c4[j] - x2[j] * s4[j]) * sc; o2[4 * n + j] = (x2[j] * c4[j] + x1[j] * s4[j]) * sc; } }
          u32x4 w1, w2; w1.x = cvt_pk_bf16(o1[0], o1[1]); w1.y = cvt_pk_bf16(o1[2], o1[3]); w1.z = cvt_pk_bf16(o1[4], o1[5]); w1.w = cvt_pk_bf16(o1[6], o1[7]);
          w2.x = cvt_pk_bf16(o2[0], o2[1]); w2.y = cvt_pk_bf16(o2[2], o2[3]); w2.z = cvt_pk_bf16(o2[4], o2[5]); w2.w = cvt_pk_bf16(o2[6], o2[7]);
          if (isk) { bf16_t* rp = dst + (size_t)lr * 1024 + head * 256 + cin; *(u32x4*)rp = w1; *(u32x4*)(rp + 128) = w2; }
          else {
            bf16_t* qb = dst + ((size_t)((lr >> 6) * 4 + head) * 4 + m) * 4096 + (size_t)(fq * 16 + fr) * 8;
            *(u32x4*)(qb + wc * 512) = w1; *(u32x4*)(qb + (4 + wc) * 512) = w2; }
        }
    } else {
      const bool isg = pn >= 16; bf16_t* dst = isg ? RG : RV; const int cbase = (isg ? pn - 16 : pn - 8) * 256 + cin;
#pragma unroll
      for (int ai = 0; ai < 2; ++ai)
#pragma unroll
        for (int m = 0; m < 4; ++m) { bf16_t* rowp = dst + (size_t)(row0 + ai * HALF + m * 16) * 2048 + cbase;
#pragma unroll
          for (int bj = 0; bj < 2; ++bj) { f32x4 v0 = acc[ai][bj][m][0], v1 = acc[ai][bj][m][1];
            if (isg) {
#pragma unroll
              for (int j = 0; j < 4; ++j) { v0[j] = silu_f(v0[j]); v1[j] = silu_f(v1[j]); } }
            u32x4 w; w.x = cvt_pk_bf16(v0[0], v0[1]); w.y = cvt_pk_bf16(v0[2], v0[3]); w.z = cvt_pk_bf16(v1[0], v1[1]); w.w = cvt_pk_bf16(v1[2], v1[3]);
            *(u32x4*)(rowp + bj * HALF) = w; } }
    }
  }
};
}

namespace att {
constexpr int KVBLK = 64;
constexpr float SCALE = 0.07216878364870323f;
constexpr float THR = 8.f;
constexpr int SHM_K = KVBLK * 192 * 2, SHM_V = KVBLK * 128 * 2;
#define KSWZ(row, colB) ((row) * 384 + ((colB) ^ (((row) & 7) << 4)))
#define SBAR() __builtin_amdgcn_sched_barrier(0)
__device__ __forceinline__ int crow(int r, int hi) { return (r & 3) + 8 * (r >> 2) + 4 * hi; }
__device__ __forceinline__ void partialSM(f32x16& p0, f32x16& p1, float& m_reg, float& mn, float& alpha) {
  constexpr float C = SCALE * 1.4426950408889634f;
  float pmax = p0[0];
#pragma unroll
  for (int r = 1; r < 16; ++r) pmax = fmaxf(pmax, p0[r]);
#pragma unroll
  for (int r = 0; r < 16; ++r) pmax = fmaxf(pmax, p1[r]);
  { auto rr = __builtin_amdgcn_permlane32_swap(__float_as_uint(pmax), __float_as_uint(pmax), false, false);
    pmax = fmaxf(__uint_as_float(rr[0]), __uint_as_float(rr[1])); }
  if (__builtin_expect(__all(pmax - m_reg <= THR / SCALE), 1)) { mn = m_reg; alpha = 1.f; }
  else { mn = fmaxf(m_reg, pmax); alpha = __builtin_amdgcn_exp2f((m_reg - mn) * C); m_reg = mn; }
  const float mnC = -mn * C;
#pragma unroll
  for (int r = 0; r < 16; ++r) p0[r] = __builtin_amdgcn_exp2f(fmaf(p0[r], C, mnC));
#pragma unroll
  for (int r = 0; r < 16; ++r) p1[r] = __builtin_amdgcn_exp2f(fmaf(p1[r], C, mnC));
}
__device__ __forceinline__ void finishSM(f32x16& p0, f32x16& p1, float alpha, float& l_reg, bf16x8& pa0, bf16x8& pa1, bf16x8& pa2, bf16x8& pa3) {
  float ps = 0;
#pragma unroll
  for (int r = 0; r < 16; ++r) ps += p0[r];
#pragma unroll
  for (int r = 0; r < 16; ++r) ps += p1[r];
  { auto rr = __builtin_amdgcn_permlane32_swap(__float_as_uint(ps), __float_as_uint(ps), false, false);
    ps = __uint_as_float(rr[0]) + __uint_as_float(rr[1]); }
  l_reg = l_reg * alpha + ps;
#define PK4(P, BASE, OUT) do { unsigned a0 = cvt_pk_bf16(P[BASE + 0], P[BASE + 1]), a1 = cvt_pk_bf16(P[BASE + 2], P[BASE + 3]);   \
    unsigned b0 = cvt_pk_bf16(P[BASE + 4], P[BASE + 5]), b1 = cvt_pk_bf16(P[BASE + 6], P[BASE + 7]);                              \
    auto r0 = __builtin_amdgcn_permlane32_swap(a0, b0, false, false); auto r1 = __builtin_amdgcn_permlane32_swap(a1, b1, false, false); \
    u32x4 w = {r0[0], r1[0], r0[1], r1[1]}; OUT = *reinterpret_cast<bf16x8*>(&w); } while (0)
  PK4(p0, 0, pa0); PK4(p0, 8, pa1); PK4(p1, 0, pa2); PK4(p1, 8, pa3);
#undef PK4
}
__device__ __forceinline__ void qkt(f32x16& p0, f32x16& p1, const char* Ks, const bf16x8* qr, int r32, int hi) {
  p0 = f32x16{}; p1 = f32x16{};
  bf16x8 k0[3], k1[3];
#define KLD(S, D0) do { const int cb = ((D0) * 16 + hi * 8) * 2; k0[S] = *reinterpret_cast<const bf16x8*>(Ks + KSWZ(r32, cb)); k1[S] = *reinterpret_cast<const bf16x8*>(Ks + KSWZ(32 + r32, cb)); } while (0)
  KLD(0, 0); KLD(1, 1);
#pragma unroll
  for (int d0 = 0; d0 < 12; ++d0) {
    if (d0 + 2 < 12) KLD((d0 + 2) % 3, d0 + 2);
    SBAR();
    p0 = __builtin_amdgcn_mfma_f32_32x32x16_bf16(k0[d0 % 3], qr[d0], p0, 0, 0, 0);
    p1 = __builtin_amdgcn_mfma_f32_32x32x16_bf16(k1[d0 % 3], qr[d0], p1, 0, 0, 0);
    SBAR();
  }
#undef KLD
}
__device__ __forceinline__ int v_st(int k, int c) { const int kk = (k & ~0xC) | ((k & 4) << 1) | ((k & 8) >> 1); return ((kk >> 3) * 4 + (c >> 5)) * 512 + ((kk & 7) * 32 + (c & 31)) * 2; }
__device__ __forceinline__ int v_rd_base(int lane) { return ((lane & 3) << 3) | (((lane >> 2) & 3) << 6) | (((lane >> 4) & 1) << 5) | (((lane >> 5) & 1) << 8); }
constexpr int v_rd_off(int d0, int ks, int half) { return d0 * 512 + ks * 4096 + half * 2048; }
template <int OFF> __device__ __forceinline__ s16x4 tr_read(int vb) {
  s16x4 r; asm volatile("ds_read_b64_tr_b16 %0, %1 offset:%2" : "=&v"(r) : "v"(vb), "i"(OFF) : "memory"); return r;
}
template <int D0> __device__ __forceinline__ void pv_reads(s16x4 (&r)[8], int vb) {
  r[0] = tr_read<v_rd_off(D0, 0, 0)>(vb); r[1] = tr_read<v_rd_off(D0, 0, 1)>(vb); r[2] = tr_read<v_rd_off(D0, 1, 0)>(vb); r[3] = tr_read<v_rd_off(D0, 1, 1)>(vb);
  r[4] = tr_read<v_rd_off(D0, 2, 0)>(vb); r[5] = tr_read<v_rd_off(D0, 2, 1)>(vb); r[6] = tr_read<v_rd_off(D0, 3, 0)>(vb); r[7] = tr_read<v_rd_off(D0, 3, 1)>(vb);
}
__device__ __forceinline__ void pv_mma(f32x16& od, const s16x4 (&r)[8], bf16x8 pa0, bf16x8 pa1, bf16x8 pa2, bf16x8 pa3) {
#define PK(L, H) (bf16x8){L[0], L[1], L[2], L[3], H[0], H[1], H[2], H[3]}
  od = __builtin_amdgcn_mfma_f32_32x32x16_bf16(pa0, PK(r[0], r[1]), od, 0, 0, 0);
  od = __builtin_amdgcn_mfma_f32_32x32x16_bf16(pa1, PK(r[2], r[3]), od, 0, 0, 0);
  od = __builtin_amdgcn_mfma_f32_32x32x16_bf16(pa2, PK(r[4], r[5]), od, 0, 0, 0);
  od = __builtin_amdgcn_mfma_f32_32x32x16_bf16(pa3, PK(r[6], r[7]), od, 0, 0, 0);
#undef PK
}
__device__ __forceinline__ void pv_d0(f32x16* o, int vb, bf16x8 pa0, bf16x8 pa1, bf16x8 pa2, bf16x8 pa3) {
  s16x4 ra[8], rb[8];
  pv_reads<0>(ra, vb); pv_reads<1>(rb, vb);
  asm volatile("s_waitcnt lgkmcnt(8)" ::: "memory"); SBAR(); pv_mma(o[0], ra, pa0, pa1, pa2, pa3); SBAR();
  pv_reads<2>(ra, vb);
  asm volatile("s_waitcnt lgkmcnt(8)" ::: "memory"); SBAR(); pv_mma(o[1], rb, pa0, pa1, pa2, pa3); SBAR();
  pv_reads<3>(rb, vb);
  asm volatile("s_waitcnt lgkmcnt(8)" ::: "memory"); SBAR(); pv_mma(o[2], ra, pa0, pa1, pa2, pa3); SBAR();
  asm volatile("s_waitcnt lgkmcnt(0)" ::: "memory"); SBAR(); pv_mma(o[3], rb, pa0, pa1, pa2, pa3);
}
__device__ __forceinline__ void attn_unit(const bf16_t* __restrict__ Qb, const bf16_t* __restrict__ KVh, const bf16_t* __restrict__ KPEh, bf16_t* __restrict__ Ob, int seq, char* lds, int ldsoff) {
  const int tid = tidx(), wid = tid >> 6, lane = tid & 63, r32 = lane & 31, hi = lane >> 5;
  char* V_lds = lds; char* K_lds = lds + 2 * SHM_V;
  float* ws = (float*)(lds + 2 * SHM_V + 2 * SHM_K) + wid * 64; float* li_l = ws; float* al_l = ws + 32;
  float m_reg = -1e30f, l_reg = 0; f32x16 o[4] = {}; bf16x8 qr[12];
  const bf16_t* Qw = Qb + (long)(wid * 32 + r32) * 1536 + hi * 8;
#pragma unroll
  for (int d0 = 0; d0 < 12; ++d0) qr[d0] = *reinterpret_cast<const bf16x8*>(Qw + d0 * 16);
  const int sr = tid >> 4, sc = (tid & 15) * 8, vst0 = v_st(sr, sc), vst1 = v_st(32 + sr, sc);
  const int pr = tid >> 3, pc = (tid & 7) * 8;
  const int vb0 = ldsoff + v_rd_base(lane);
  bf16x8 vs0, vs1, ks0, ks1, kp;
#define SLOAD(k0) do { vs0 = *reinterpret_cast<const bf16x8*>(&KVh[(long)((k0) + sr) * 2048 + 128 + sc]); vs1 = *reinterpret_cast<const bf16x8*>(&KVh[(long)((k0) + 32 + sr) * 2048 + 128 + sc]); \
    ks0 = *reinterpret_cast<const bf16x8*>(&KVh[(long)((k0) + sr) * 2048 + sc]); ks1 = *reinterpret_cast<const bf16x8*>(&KVh[(long)((k0) + 32 + sr) * 2048 + sc]); \
    kp = *reinterpret_cast<const bf16x8*>(&KPEh[(long)((k0) + pr) * 512 + pc]); } while (0)
#define SWRITE(b) do { *(bf16x8*)(V_lds + (b) * SHM_V + vst0) = vs0; *(bf16x8*)(V_lds + (b) * SHM_V + vst1) = vs1; \
    *(bf16x8*)(K_lds + (b) * SHM_K + KSWZ(sr, sc * 2)) = ks0; *(bf16x8*)(K_lds + (b) * SHM_K + KSWZ(32 + sr, sc * 2)) = ks1; \
    *(bf16x8*)(K_lds + (b) * SHM_K + KSWZ(pr, (128 + pc) * 2)) = kp; } while (0)
  f32x16 p0, p1; float mn, al; bf16x8 pa0, pa1, pa2, pa3; const int NT = seq / KVBLK;
  SLOAD(0); asm volatile("s_waitcnt vmcnt(0)" ::: "memory"); SWRITE(0); __syncthreads();
  for (int j = 0; j < NT; ++j) {
    const int b = j & 1;
    if (j + 1 < NT) SLOAD((j + 1) * KVBLK);
    SBAR();
    qkt(p0, p1, K_lds + b * SHM_K, qr, r32, hi);
    partialSM(p0, p1, m_reg, mn, al);
    if (__any(al < 1.f)) { if (hi == 0) al_l[r32] = al; asm volatile("s_waitcnt lgkmcnt(0)" ::: "memory");
#pragma unroll
      for (int d = 0; d < 4; ++d)
#pragma unroll
        for (int r = 0; r < 16; ++r) o[d][r] *= al_l[crow(r, hi)]; }
    finishSM(p0, p1, al, l_reg, pa0, pa1, pa2, pa3); SBAR();
    pv_d0(o, vb0 + b * SHM_V, pa0, pa1, pa2, pa3);
    if (j + 1 < NT) { asm volatile("s_waitcnt vmcnt(0)" ::: "memory"); SWRITE(b ^ 1); }
    __syncthreads();
  }
  if (hi == 0) li_l[r32] = l_reg; asm volatile("s_waitcnt lgkmcnt(0)" ::: "memory");
  float rli[16];
#pragma unroll
  for (int r = 0; r < 16; ++r) rli[r] = __builtin_amdgcn_rcpf(li_l[crow(r, hi)]);
  bf16_t* Ow = Ob + (long)(wid * 32) * 1024;
#pragma unroll
  for (int r = 0; r < 16; ++r) { const int orow = crow(r, hi);
#pragma unroll
    for (int d0 = 0; d0 < 4; ++d0) Ow[(long)orow * 1024 + d0 * 32 + r32] = f2bf(o[d0][r] * rli[r]); }
  __syncthreads();
#undef SLOAD
#undef SWRITE
}
}

namespace ret {
constexpr int RS = 528, TS = 144;
constexpr int QS = 0, KS = 33792;
constexpr int KTS = 0, STS = 36864, PS = 53760, VRS = 62976, VZS = 68096, OTS = 73216, VST = 80;
__device__ __forceinline__ f32x4 mma16(bf16x8 a, bf16x8 b, f32x4 c) { return __builtin_amdgcn_mfma_f32_16x16x32_bf16(a, b, c, 0, 0, 0); }
typedef short v4i16_t __attribute__((ext_vector_type(4)));
__device__ __forceinline__ bf16x8 vtr_frag_s(const LAS unsigned char* p0, int l15, int stride) {
  const LAS unsigned char* p = p0 + (l15 >> 2) * stride + (l15 & 3) * 8;
  const v4i16_t lo = __builtin_amdgcn_ds_read_tr16_b64_v4i16((LAS v4i16_t*)p), hi = __builtin_amdgcn_ds_read_tr16_b64_v4i16((LAS v4i16_t*)(p + 4 * stride));
  return (bf16x8){lo[0], lo[1], lo[2], lo[3], hi[0], hi[1], hi[2], hi[3]};
}
__device__ __forceinline__ bf16x8 vtr_frag(const LAS unsigned char* p0, int l15) { return vtr_frag_s(p0, l15, VST); }
__device__ __forceinline__ void p_unit(LAS unsigned char* L, const bf16_t* __restrict__ RQ, const bf16_t* __restrict__ RK, bf16_t* __restrict__ RKT, bf16_t* __restrict__ Pg, int c, int hd, float lg2f, float lg2b) {
  const int tid = tidx(), wid = tid >> 6, lane = tid & 63, l15 = lane & 15, g4 = lane >> 4;
  const int it = wid >> 1, jt0 = 2 * (wid & 1);
  const long tok0 = (long)c * 64;
#pragma unroll
  for (int i = 0; i < 4; ++i) { const int q = tid + 512 * i; const int row = q >> 5, c16 = q & 31;
    const u32x4 b = *(const u32x4*)(RK + (tok0 + row) * 1024 + hd * 256 + c16 * 8);
    *(LAS u32x4*)(L + KS + row * RS + c16 * 16) = b; }
  bf16x8 qa[8];
  { const bf16_t* qb_ = RQ + ((size_t)(c * 4 + hd) * 4 + it) * 4096 + lane * 8;
#pragma unroll
    for (int ks = 0; ks < 8; ++ks) qa[ks] = *(const bf16x8*)(qb_ + ks * 512); }
  __syncthreads();
#pragma unroll
  for (int a = 0; a < 2; ++a)
#pragma unroll
    for (int ks = 0; ks < 2; ++ks) { const int dt = 2 * wid + a;
      const bf16x8 f = vtr_frag_s(L + KS + (ks * 32 + 8 * g4) * RS + dt * 32, l15, RS);
      *(bf16x8*)(RKT + ((size_t)(c * 4 + hd) * 16 + dt) * 1024 + ks * 512 + lane * 8) = f; }
  f32x4 sS0 = {0.f, 0.f, 0.f, 0.f}, sS1 = {0.f, 0.f, 0.f, 0.f};
#pragma unroll
  for (int ks = 0; ks < 8; ++ks) { const int ko = (ks * 32 + 8 * g4) * 2;
    const bf16x8 a = qa[ks];
    const bf16x8 b0 = *(const LAS bf16x8*)(L + KS + (16 * jt0 + l15) * RS + ko);
    const bf16x8 b1 = *(const LAS bf16x8*)(L + KS + (16 * (jt0 + 1) + l15) * RS + ko);
    sS0 = mma16(a, b0, sS0); sS1 = mma16(a, b1, sS1); }
  bf16_t* Pf = Pg + ((size_t)(c * 4 + hd) * 2) * 4096; bf16_t* Pb = Pf + 4096;
#pragma unroll
  for (int r = 0; r < 4; ++r) { const int i = 16 * it + 4 * g4 + r; const int j0 = 16 * jt0 + l15, j1 = j0 + 16;
    const float f0 = (i >= j0) ? __builtin_amdgcn_exp2f((float)(i - j0) * lg2f) : 0.f, f1 = (i >= j1) ? __builtin_amdgcn_exp2f((float)(i - j1) * lg2f) : 0.f;
    const float b0 = (j0 > i) ? __builtin_amdgcn_exp2f((float)(j0 - i) * lg2b) : 0.f, b1 = (j1 > i) ? __builtin_amdgcn_exp2f((float)(j1 - i) * lg2b) : 0.f;
    Pf[i * 64 + j0] = f2bf(sS0[r] * f0); Pf[i * 64 + j1] = f2bf(sS1[r] * f1);
    Pb[i * 64 + j0] = f2bf(sS0[r] * b0); Pb[i * 64 + j1] = f2bf(sS1[r] * b1); }
  __syncthreads();
}
__device__ __forceinline__ void scan_item(LAS unsigned char* L, const bf16_t* __restrict__ RQ, const bf16_t* __restrict__ RKT, const bf16_t* __restrict__ RV, const bf16_t* __restrict__ Pg,
                                          bf16_t* __restrict__ Oo, int seqlen, int s, int hd, int dir, int sl, float lg2) {
  const int tid = tidx(), wid = __builtin_amdgcn_readfirstlane(tid >> 6), lane = tid & 63, l15 = lane & 15, g4 = lane >> 4;
  const int nchunk = seqlen >> 6;
  const long tokb = (long)s * seqlen;
#define CHUNK_OF(cc_) (dir ? nchunk - 1 - (cc_) : (cc_))
#define LOAD_P(PP, c) PP = *(const u32x4*)(Pg + ((size_t)(((tokb >> 6) + (c)) * 4 + hd) * 2 + dir) * 4096 + tid * 8)
#define STAGE_P(PP) *(LAS u32x4*)(L + PS + (tid >> 3) * TS + (tid & 7) * 16) = PP
  if (wid < 4) {
    const int it = wid;
    float xi[4];
#pragma unroll
    for (int r = 0; r < 4; ++r) { const int i = 16 * it + 4 * g4 + r; xi[r] = __builtin_amdgcn_exp2f((dir ? (float)(64 - i) : (float)(i + 1)) * lg2); }
    bf16x8 qfA[8], qfB[8]; u32x4 ppA, ppB;
#define LOAD_Q(QF, c) do { const bf16_t* qb_ = RQ + ((((tokb >> 6) + (c)) * 4 + hd) * 4 + it) * 4096 + lane * 8; \
      _Pragma("unroll") for (int ks = 0; ks < 8; ++ks) QF[ks] = *(const bf16x8*)(qb_ + ks * 512); } while (0)
#define X_STEP(QF, PP, CC) do { \
      const int c = CHUNK_OF(CC); \
      STAGE_P(PP); \
      __syncthreads(); \
      if ((CC) + 2 < nchunk) LOAD_P(PP, CHUNK_OF((CC) + 2)); \
      f32x4 c0 = {0.f, 0.f, 0.f, 0.f}, c1 = {0.f, 0.f, 0.f, 0.f}; \
      _Pragma("unroll") for (int ks = 0; ks < 8; ++ks) { const int ko = (ks * 32 + 8 * g4) * 2; \
        const bf16x8 s0 = *(const LAS bf16x8*)(L + STS + l15 * RS + ko), s1 = *(const LAS bf16x8*)(L + STS + (16 + l15) * RS + ko); \
        c0 = mma16(QF[ks], s0, c0); c1 = mma16(QF[ks], s1, c1); } \
      if ((CC) + 2 < nchunk) LOAD_Q(QF, CHUNK_OF((CC) + 2)); \
      _Pragma("unroll") for (int r = 0; r < 4; ++r) { c0[r] *= xi[r]; c1[r] *= xi[r]; } \
      _Pragma("unroll") for (int ks = 0; ks < 2; ++ks) { const int ko = (ks * 32 + 8 * g4) * 2; \
        const bf16x8 a = *(const LAS bf16x8*)(L + PS + (16 * it + l15) * TS + ko); \
        const bf16x8 v0 = vtr_frag(L + VRS + (ks * 32 + 8 * g4) * VST, l15), v1 = vtr_frag(L + VRS + (ks * 32 + 8 * g4) * VST + 32, l15); \
        c0 = mma16(a, v0, c0); c1 = mma16(a, v1, c1); } \
      _Pragma("unroll") for (int r = 0; r < 4; ++r) { \
        *(LAS unsigned short*)(L + OTS + (16 * it + 4 * g4 + r) * 80 + l15 * 2) = f2bf(c0[r]); \
        *(LAS unsigned short*)(L + OTS + (16 * it + 4 * g4 + r) * 80 + (16 + l15) * 2) = f2bf(c1[r]); } \
      __syncthreads(); \
      { const u32x4 w = *(const LAS u32x4*)(L + OTS + (tid >> 2) * 80 + (tid & 3) * 16); \
        *(u32x4*)(Oo + ((long)(hd * 16 + sl) * T_GRP + tokb + (long)c * 64 + (tid >> 2)) * 32 + (tid & 3) * 8) = w; } } while (0)
    LOAD_P(ppA, CHUNK_OF(0)); LOAD_Q(qfA, CHUNK_OF(0));
    LOAD_P(ppB, CHUNK_OF(1)); LOAD_Q(qfB, CHUNK_OF(1));
#pragma unroll 1
    for (int cc = 0; cc < nchunk; cc += 2) { X_STEP(qfA, ppA, cc); X_STEP(qfB, ppB, cc + 1); }
#undef X_STEP
#undef LOAD_Q
  } else {
    const int w4 = wid - 4, t2 = tid - 256;
    const int vrow = t2 >> 2, vc4 = t2 & 3;
    const float zeta = __builtin_amdgcn_exp2f((dir ? (float)vrow : (float)(63 - vrow)) * lg2);
    const float gch = __builtin_amdgcn_exp2f(64.f * lg2);
    f32x4 st[4][2];
#pragma unroll
    for (int a = 0; a < 4; ++a)
#pragma unroll
      for (int b = 0; b < 2; ++b) st[a][b] = (f32x4){0.f, 0.f, 0.f, 0.f};
    bf16x8 ktA[4][2], ktB[4][2]; u32x4 pvA, pvB, ppA, ppB;
#define LOAD_K(KT, c) do { const bf16_t* kb_ = RKT + (((((tokb >> 6) + (c)) * 4 + hd) * 16) + 4 * w4) * 1024 + lane * 8; \
      _Pragma("unroll") for (int a = 0; a < 4; ++a) _Pragma("unroll") for (int ks = 0; ks < 2; ++ks) KT[a][ks] = *(const bf16x8*)(kb_ + a * 1024 + ks * 512); } while (0)
#define LOAD_V(PV, c) PV = *(const u32x4*)(RV + (tokb + (long)(c) * 64 + vrow) * 2048 + hd * 512 + sl * 32 + vc4 * 8)
#define S_STEP(KT, PV, PP, CC) do { \
      STAGE_P(PP); \
      { u32x4 wz; wz.x = cvt_pk_bf16(bflo(PV.x) * zeta, bfhi(PV.x) * zeta); wz.y = cvt_pk_bf16(bflo(PV.y) * zeta, bfhi(PV.y) * zeta); \
        wz.z = cvt_pk_bf16(bflo(PV.z) * zeta, bfhi(PV.z) * zeta); wz.w = cvt_pk_bf16(bflo(PV.w) * zeta, bfhi(PV.w) * zeta); \
        *(LAS u32x4*)(L + VRS + vrow * VST + vc4 * 16) = PV; *(LAS u32x4*)(L + VZS + vrow * VST + vc4 * 16) = wz; } \
      _Pragma("unroll") for (int a = 0; a < 4; ++a) _Pragma("unroll") for (int b = 0; b < 2; ++b) { const int d = 16 * (4 * w4 + a) + 4 * g4, dv = 16 * b + l15; \
          u32x2 w; w.x = cvt_pk_bf16(st[a][b][0], st[a][b][1]); w.y = cvt_pk_bf16(st[a][b][2], st[a][b][3]); \
          *(LAS u32x2*)(L + STS + dv * RS + d * 2) = w; } \
      __syncthreads(); \
      if ((CC) + 2 < nchunk) { LOAD_P(PP, CHUNK_OF((CC) + 2)); LOAD_V(PV, CHUNK_OF((CC) + 2)); } \
      _Pragma("unroll") for (int a = 0; a < 4; ++a) _Pragma("unroll") for (int b = 0; b < 2; ++b) st[a][b] *= gch; \
      _Pragma("unroll") for (int ks = 0; ks < 2; ++ks) { \
        const bf16x8 b0 = vtr_frag(L + VZS + (ks * 32 + 8 * g4) * VST, l15), b1 = vtr_frag(L + VZS + (ks * 32 + 8 * g4) * VST + 32, l15); \
        _Pragma("unroll") for (int a = 0; a < 4; ++a) { st[a][0] = mma16(KT[a][ks], b0, st[a][0]); st[a][1] = mma16(KT[a][ks], b1, st[a][1]); } } \
      if ((CC) + 2 < nchunk) LOAD_K(KT, CHUNK_OF((CC) + 2)); \
      __syncthreads(); } while (0)
    LOAD_P(ppA, CHUNK_OF(0)); LOAD_V(pvA, CHUNK_OF(0)); LOAD_K(ktA, CHUNK_OF(0));
    LOAD_P(ppB, CHUNK_OF(1)); LOAD_V(pvB, CHUNK_OF(1)); LOAD_K(ktB, CHUNK_OF(1));
#pragma unroll 1
    for (int cc = 0; cc < nchunk; cc += 2) { S_STEP(ktA, pvA, ppA, cc); S_STEP(ktB, pvB, ppB, cc + 1); }
#undef S_STEP
#undef LOAD_K
#undef LOAD_V
  }
#undef STAGE_P
#undef LOAD_P
#undef CHUNK_OF
}
}

__device__ __forceinline__ void prep_T(float* tile, const float* __restrict__ W, int K, int N, bf16_t* __restrict__ Bt, int mode, int row_off, int& base) {
  const int G = gridDim.x, tid = tidx();
  const int tn = N >> 6, ntile = (K >> 6) * tn;
  int t0 = ((int)blockIdx.x - base % G + G) % G;
  for (int t = t0; t < ntile; t += G) {
    const int k0 = (t / tn) << 6, n0 = (t % tn) << 6;
#pragma unroll
    for (int i = 0; i < 2; ++i) { const int kr = (tid >> 4) + 32 * i, nc = (tid & 15) * 4;
      const f32x4 v = *(const f32x4*)(W + (size_t)(k0 + kr) * N + n0 + nc);
      tile[kr * 65 + nc] = v[0]; tile[kr * 65 + nc + 1] = v[1]; tile[kr * 65 + nc + 2] = v[2]; tile[kr * 65 + nc + 3] = v[3]; }
    __syncthreads();
    { const int n = tid >> 3, kc = (tid & 7) * 8; const int nn = n0 + n;
      const int orow = (mode == 0 ? nn : ((nn >> 7) * 256 + (nn & 127))) + row_off;
      u32x4 w;
      w.x = cvt_pk_bf16(tile[(kc + 0) * 65 + n], tile[(kc + 1) * 65 + n]); w.y = cvt_pk_bf16(tile[(kc + 2) * 65 + n], tile[(kc + 3) * 65 + n]);
      w.z = cvt_pk_bf16(tile[(kc + 4) * 65 + n], tile[(kc + 5) * 65 + n]); w.w = cvt_pk_bf16(tile[(kc + 6) * 65 + n], tile[(kc + 7) * 65 + n]);
      *(u32x4*)(Bt + (size_t)orow * K + k0 + kc) = w; }
    __syncthreads();
  }
  base += ntile;
}
__device__ __forceinline__ void prep_layer(float* tile, const Params& P, int layer) {
  bf16_t* Wb = (bf16_t*)(P.ws + WS_W); int base = 0; const int j = layer >> 1;
#pragma unroll 1
  for (int s = 0; s < 2; ++s) {
    const size_t off = (size_t)(layer * 2 + s) * DM * FF;
    bf16_t* gu = Wb + (s ? WE_GU1 : WE_GU0); bf16_t* dn = Wb + (s ? WE_D1 : WE_D0);
    prep_T(tile, P.ffn_g + off, DM, FF, gu, 1, 0, base);
    prep_T(tile, P.ffn_u + off, DM, FF, gu, 1, 128, base);
    prep_T(tile, P.ffn_d + off, FF, DM, dn, 0, 0, base);
  }
  if ((layer & 1) == 0) {
    prep_T(tile, P.m_dq + (size_t)j * 1024 * 384, 1024, 384, Wb + WE_DQKV, 0, 0, base);
    prep_T(tile, P.m_dkv + (size_t)j * 1024 * 320, 1024, 320, Wb + WE_DQKV, 0, 384, base);
    prep_T(tile, P.m_uq + (size_t)j * 384 * 1536, 384, 1536, Wb + WE_UQ, 0, 0, base);
    prep_T(tile, P.m_ukv + (size_t)j * 256 * 2048, 256, 2048, Wb + WE_UKV, 0, 0, base);
    prep_T(tile, P.m_wo + (size_t)j * 1024 * 1024, 1024, 1024, Wb + WE_MO, 0, 0, base);
    bf16_t* z = Wb + WE_DQKV + (size_t)704 * 1024;
    for (int i = blockIdx.x * 512 + tidx(); i < 64 * 1024 / 8; i += gridDim.x * 512) *(u32x4*)(z + (size_t)i * 8) = (u32x4){0u, 0u, 0u, 0u};
  } else {
    prep_T(tile, P.r_in + (size_t)j * 1024 * 6144, 1024, 6144, Wb + WE_RIN, 0, 0, base);
    prep_T(tile, P.r_wo + (size_t)j * 2048 * 1024, 2048, 1024, Wb + WE_RO, 0, 0, base);
  }
}
__device__ __forceinline__ void build_tables(const Params& P) {
  float* c64 = (float*)(P.ws + WS_TAB); float* s64 = c64 + 8192 * 32; float* c256 = s64 + 8192 * 32; float* s256 = c256 + 8192 * 128;
  const int lane = tidx() & 63, gw = blockIdx.x * 8 + (tidx() >> 6), nw = gridDim.x * 8;
  for (int pos = gw; pos < 8192; pos += nw)
  for (int k = lane; k < 160; k += 64) {
    double rb = (k < 32) ? 0.7498942093324559 : 0.930572040929699; int e = (k < 32) ? k : k - 32; double inv = 1.0;
#pragma unroll 1
    for (; e > 0; e >>= 1) { if (e & 1) inv *= rb; rb *= rb; }
    const double rev = (double)pos * inv * 0.15915494309189535;
    const float f = (float)(rev - rint(rev));
    const float c = __builtin_amdgcn_cosf(f), s = __builtin_amdgcn_sinf(f);
    if (k < 32) { c64[pos * 32 + k] = c; s64[pos * 32 + k] = s; } else { c256[pos * 128 + k - 32] = c; s256[pos * 128 + k - 32] = s; }
  }
}
__device__ __forceinline__ void rows_norm(int mode, const Params& P, const float* __restrict__ g1, const float* __restrict__ g2) {
  bf16_t* H = (bf16_t*)P.out; bf16_t* XN = (bf16_t*)(P.ws + WS_XN); float* OUTF = (float*)(P.ws + WS_S);
  const int lane = tidx() & 63, gw = blockIdx.x * 8 + (tidx() >> 6), nw = gridDim.x * 8;
  for (int row0 = gw; row0 < T_ALL; row0 += 2 * nw) {
    f32x4 vv[2][4];
#pragma unroll
    for (int h = 0; h < 2; ++h) { const int row = row0 + h * nw; if (row < T_ALL) {
        if (mode == 0) { const float* src = row < T_GRP ? P.xp + (size_t)row * DM : P.xs + (size_t)(row - T_GRP) * DM;
#pragma unroll
          for (int i = 0; i < 4; ++i) vv[h][i] = *(const f32x4*)(src + i * 256 + lane * 4);
        } else {
#pragma unroll
          for (int i = 0; i < 4; ++i) { const u32x2 w = *(const u32x2*)(H + (size_t)row * DM + i * 256 + lane * 4); vv[h][i] = (f32x4){bflo(w.x), bfhi(w.x), bflo(w.y), bfhi(w.y)}; } } } }
#pragma unroll
    for (int h = 0; h < 2; ++h) { const int row = row0 + h * nw; if (row >= T_ALL) continue;
      f32x4 v[4]; float ss = 0.f;
#pragma unroll
      for (int i = 0; i < 4; ++i) { v[i] = vv[h][i]; ss += v[i][0] * v[i][0] + v[i][1] * v[i][1] + v[i][2] * v[i][2] + v[i][3] * v[i][3]; }
      ss = wave_sum(ss); const float rstd = rsqrtf(ss * (1.f / DM) + EPS);
      if (mode == 0) {
#pragma unroll
        for (int i = 0; i < 4; ++i) { u32x2 w; w.x = cvt_pk_bf16(v[i][0], v[i][1]); w.y = cvt_pk_bf16(v[i][2], v[i][3]); *(u32x2*)(H + (size_t)row * DM + i * 256 + lane * 4) = w; } }
      float ss2 = 0.f;
#pragma unroll
      for (int i = 0; i < 4; ++i) { const f32x4 gg = *(const f32x4*)(g1 + i * 256 + lane * 4); v[i] = v[i] * rstd * gg; ss2 += v[i][0] * v[i][0] + v[i][1] * v[i][1] + v[i][2] * v[i][2] + v[i][3] * v[i][3]; }
      if (mode == 3) {
        float* dst = (row >= T_ALL / 2) ? P.out : OUTF;
#pragma unroll
        for (int i = 0; i < 4; ++i) *(f32x4*)(dst + (size_t)row * DM + i * 256 + lane * 4) = v[i];
        continue; }
      if (mode == 2) {
#pragma unroll
        for (int i = 0; i < 4; ++i) { u32x2 w; w.x = cvt_pk_bf16(v[i][0], v[i][1]); w.y = cvt_pk_bf16(v[i][2], v[i][3]); *(u32x2*)(H + (size_t)row * DM + i * 256 + lane * 4) = w; }
        ss2 = wave_sum(ss2); const float rstd2 = rsqrtf(ss2 * (1.f / DM) + EPS);
#pragma unroll
        for (int i = 0; i < 4; ++i) { const f32x4 gg = *(const f32x4*)(g2 + i * 256 + lane * 4); v[i] = v[i] * rstd2 * gg; }
      }
#pragma unroll
      for (int i = 0; i < 4; ++i) { u32x2 w; w.x = cvt_pk_bf16(v[i][0], v[i][1]); w.y = cvt_pk_bf16(v[i][2], v[i][3]); *(u32x2*)(XN + (size_t)row * DM + i * 256 + lane * 4) = w; }
    }
  }
}
__device__ __forceinline__ void copy_out(const Params& P) {
  const u32x4* s = (const u32x4*)(P.ws + WS_S); u32x4* d = (u32x4*)P.out;
  const size_t n = (size_t)(T_ALL / 2) * DM / 4, nth = (size_t)gridDim.x * 512;
  for (size_t i = (size_t)blockIdx.x * 512 + tidx(); i < n; i += nth) d[i] = s[i];
}
__device__ __forceinline__ void rows_mla_a(const Params& P, int j) {
  bf16_t* C = (bf16_t*)(P.ws + WS_S + S_CQKV); const float* qa = P.m_qa + j * 384; const float* kva = P.m_kva + j * 256;
  const int lane = tidx() & 63, gw = blockIdx.x * 8 + (tidx() >> 6), nw = gridDim.x * 8;
  for (int row = gw; row < T_ALL; row += nw) {
    bf16_t* r = C + (size_t)row * 768;
    unsigned q[3]; float ssq = 0.f;
#pragma unroll
    for (int i = 0; i < 3; ++i) { q[i] = *(const unsigned*)(r + i * 128 + lane * 2); const float a = bflo(q[i]), b = bfhi(q[i]); ssq += a * a + b * b; }
    const u32x2 kk = *(const u32x2*)(r + 384 + lane * 4);
    float kv[4] = {bflo(kk.x), bfhi(kk.x), bflo(kk.y), bfhi(kk.y)};
    float ssk = kv[0] * kv[0] + kv[1] * kv[1] + kv[2] * kv[2] + kv[3] * kv[3];
    ssq = wave_sum(ssq); ssk = wave_sum(ssk);
    const float rq = rsqrtf(ssq * (1.f / 384.f) + EPS), rk = rsqrtf(ssk * (1.f / 256.f) + EPS);
#pragma unroll
    for (int i = 0; i < 3; ++i) { const int c = i * 128 + lane * 2; *(unsigned*)(r + c) = cvt_pk_bf16(bflo(q[i]) * rq * qa[c], bfhi(q[i]) * rq * qa[c + 1]); }
    { const int c = lane * 4; u32x2 w; w.x = cvt_pk_bf16(kv[0] * rk * kva[c], kv[1] * rk * kva[c + 1]); w.y = cvt_pk_bf16(kv[2] * rk * kva[c + 2], kv[3] * rk * kva[c + 3]); *(u32x2*)(r + 384 + c) = w; }
  }
}
__device__ __forceinline__ void rows_mla_b(const Params& P, int j, int grp) {
  bf16_t* Qg = (bf16_t*)(P.ws + WS_S + S_Q); bf16_t* KVg = (bf16_t*)(P.ws + WS_S + S_KV); bf16_t* KPE = (bf16_t*)(P.ws + WS_S + S_KPE);
  const bf16_t* C = (const bf16_t*)(P.ws + WS_S + S_CQKV);
  const float* qn = P.m_qn + j * 192; const float* kn = P.m_kn + j * 192;
  const float* c64 = (const float*)(P.ws + WS_TAB); const float* s64 = c64 + 8192 * 32;
  const int lane = tidx() & 63, gw = blockIdx.x * 8 + (tidx() >> 6), nw = gridDim.x * 8;
  const int hd = lane >> 3, sub = lane & 7; const int seqmask = grp == 0 ? 4095 : 8191;
  for (int t0 = gw; t0 < T_GRP; t0 += 2 * nw) {
    u32x4 qw[2][3], kw[2][3]; f32x4 cw[2][2], sw[2][2];
#pragma unroll
    for (int h = 0; h < 2; ++h) { const int t = t0 + h * nw; if (t < T_GRP) {
        const int pos = t & seqmask; const size_t grow = (size_t)grp * T_GRP + t;
        const float* cp = c64 + pos * 32 + (sub & 3) * 8; const float* sp = s64 + pos * 32 + (sub & 3) * 8;
        cw[h][0] = *(const f32x4*)cp; cw[h][1] = *(const f32x4*)(cp + 4); sw[h][0] = *(const f32x4*)sp; sw[h][1] = *(const f32x4*)(sp + 4);
        const bf16_t* qp = Qg + (size_t)t * 1536 + hd * 192 + sub * 8; const bf16_t* kp = KVg + (size_t)t * 2048 + hd * 256 + sub * 8;
#pragma unroll
        for (int c = 0; c < 3; ++c) qw[h][c] = *(const u32x4*)(qp + 64 * c);
        kw[h][0] = *(const u32x4*)kp; kw[h][1] = *(const u32x4*)(kp + 64); kw[h][2] = *(const u32x4*)(C + grow * 768 + 640 + sub * 8); } }
#pragma unroll
    for (int h = 0; h < 2; ++h) { const int t = t0 + h * nw; if (t >= T_GRP) continue;
      float cs[8], sn[8];
#pragma unroll
      for (int e = 0; e < 4; ++e) { cs[e] = cw[h][0][e]; cs[4 + e] = cw[h][1][e]; sn[e] = sw[h][0][e]; sn[4 + e] = sw[h][1][e]; }
#pragma unroll
      for (int qk = 0; qk < 2; ++qk) {
        const float* gnv = qk ? kn : qn;
        float x[24]; float ss = 0.f;
#pragma unroll
        for (int c = 0; c < 3; ++c) { const u32x4 w = qk ? kw[h][c] : qw[h][c]; const unsigned ww[4] = {w.x, w.y, w.z, w.w};
#pragma unroll
          for (int e = 0; e < 4; ++e) { x[c * 8 + 2 * e] = bflo(ww[e]); x[c * 8 + 2 * e + 1] = bfhi(ww[e]); } }
#pragma unroll
        for (int e = 0; e < 24; ++e) ss += x[e] * x[e];
        ss += __shfl_xor(ss, 1); ss += __shfl_xor(ss, 2); ss += __shfl_xor(ss, 4);
        const float rstd = rsqrtf(ss * (1.f / 192.f) + EPS);
#pragma unroll
        for (int c = 0; c < 3; ++c)
#pragma unroll
          for (int e = 0; e < 8; ++e) x[c * 8 + e] *= rstd * gnv[c * 64 + sub * 8 + e];
#pragma unroll
        for (int e = 0; e < 8; ++e) { const float own = x[16 + e]; const float oth = __shfl_xor(own, 4);
          x[16 + e] = (sub < 4) ? (own * cs[e] - oth * sn[e]) : (own * cs[e] + oth * sn[e]); }
        u32x4 wo[3];
#pragma unroll
        for (int c = 0; c < 3; ++c) { wo[c].x = cvt_pk_bf16(x[c * 8], x[c * 8 + 1]); wo[c].y = cvt_pk_bf16(x[c * 8 + 2], x[c * 8 + 3]); wo[c].z = cvt_pk_bf16(x[c * 8 + 4], x[c * 8 + 5]); wo[c].w = cvt_pk_bf16(x[c * 8 + 6], x[c * 8 + 7]); }
        if (qk == 0) { bf16_t* qp = Qg + (size_t)t * 1536 + hd * 192 + sub * 8; *(u32x4*)qp = wo[0]; *(u32x4*)(qp + 64) = wo[1]; *(u32x4*)(qp + 128) = wo[2]; }
        else { bf16_t* kp = KVg + (size_t)t * 2048 + hd * 256 + sub * 8; *(u32x4*)kp = wo[0]; *(u32x4*)(kp + 64) = wo[1]; *(u32x4*)(KPE + (size_t)t * 512 + hd * 64 + sub * 8) = wo[2]; }
      }
    }
  }
}
__device__ __forceinline__ void rows_ret_gn(const Params& P, int j) {
  bf16_t* Y = (bf16_t*)(P.ws + WS_S + S_RQ); const bf16_t* OF = (const bf16_t*)(P.ws + WS_S + S_OF); const bf16_t* OB = (const bf16_t*)(P.ws + WS_S + S_OB); const bf16_t* RG = (const bf16_t*)(P.ws + WS_S + S_RG);
  const float* gn = P.r_gn + j * 2048;
  const int lane = tidx() & 63, gw = blockIdx.x * 8 + (tidx() >> 6), nw = gridDim.x * 8;
  for (int task0 = gw; task0 < T_GRP * 4; task0 += 4 * nw) {
    u32x4 av[4], bv[4], gv[4];
#pragma unroll
    for (int h = 0; h < 4; ++h) { const int task = task0 + h * nw; if (task < T_GRP * 4) {
        const size_t off = (size_t)(task >> 2) * 2048 + (task & 3) * 512 + lane * 8;
        const size_t offo = ((size_t)((task & 3) * 16 + (lane >> 2)) * T_GRP + (task >> 2)) * 32 + (lane & 3) * 8;
        av[h] = *(const u32x4*)(OF + offo); bv[h] = *(const u32x4*)(OB + offo); gv[h] = *(const u32x4*)(RG + off); } }
#pragma unroll
    for (int h = 0; h < 4; ++h) { const int task = task0 + h * nw; if (task >= T_GRP * 4) continue;
      const size_t off = (size_t)(task >> 2) * 2048 + (task & 3) * 512 + lane * 8;
      const u32x4 a = av[h], b = bv[h], g = gv[h];
      const unsigned aw[4] = {a.x, a.y, a.z, a.w}, bw[4] = {b.x, b.y, b.z, b.w}, gw4[4] = {g.x, g.y, g.z, g.w};
      float o[8]; float sm = 0.f;
#pragma unroll
      for (int e = 0; e < 4; ++e) { o[2 * e] = bflo(aw[e]) + bflo(bw[e]); o[2 * e + 1] = bfhi(aw[e]) + bfhi(bw[e]); sm += o[2 * e] + o[2 * e + 1]; }
      sm = wave_sum(sm); const float mu = sm * (1.f / 512.f);
      float vs = 0.f;
#pragma unroll
      for (int e = 0; e < 8; ++e) { o[e] -= mu; vs += o[e] * o[e]; }
      vs = wave_sum(vs); const float rstd = rsqrtf(vs * (1.f / 512.f) + EPS);
      const float* gp = gn + (task & 3) * 512 + lane * 8;
      float y[8];
#pragma unroll
      for (int e = 0; e < 4; ++e) { y[2 * e] = o[2 * e] * rstd * gp[2 * e] * bflo(gw4[e]); y[2 * e + 1] = o[2 * e + 1] * rstd * gp[2 * e + 1] * bfhi(gw4[e]); }
      u32x4 w; w.x = cvt_pk_bf16(y[0], y[1]); w.y = cvt_pk_bf16(y[2], y[3]); w.z = cvt_pk_bf16(y[4], y[5]); w.w = cvt_pk_bf16(y[6], y[7]);
      *(u32x4*)(Y + off) = w;
    }
  }
}


#define XB_TMO      128
#define XB_XCNT(j)  (256  + 64 * (j))
#define XB_XSUB(j)  (1280 + 64 * (j))
#define XB_XGEN(j)  (2304 + 64 * (j))
#define XB_TOP      3328
#define XB_TOPGEN   3392
#define XCD_BAR_WORDS 3456
#define XB_SPIN_CAP (1u << 22)
__device__ __forceinline__ unsigned xb_ld(unsigned* p)              { return __hip_atomic_load(p, __ATOMIC_RELAXED, __HIP_MEMORY_SCOPE_AGENT); }
__device__ __forceinline__ unsigned xb_add(unsigned* p, unsigned v) { return __hip_atomic_fetch_add(p, v, __ATOMIC_RELAXED, __HIP_MEMORY_SCOPE_AGENT); }
__device__ __forceinline__ unsigned xb_xcc_id() { return (unsigned)__builtin_amdgcn_s_getreg((3 << 11) | 20) & 0xFu; }
#define XB_SPIN(cond, bar) do { unsigned _sp = 0; while (cond) { __builtin_amdgcn_s_sleep(1); \
    if ((++_sp & 255u) == 0u) { if (xb_ld(&(bar)[XB_TMO])) break; if (_sp > XB_SPIN_CAP) { atomicAdd(&(bar)[XB_TMO], 1u); break; } } } } while (0)
__device__ __forceinline__ void xcd_barrier_complete(unsigned* bar, unsigned x, unsigned& nloc, unsigned& nx) {
    const unsigned G = gridDim.x;
    unsigned sum, cnt, mine, sp = 0u;
    for (;;) {
        sum = 0u; cnt = 0u; mine = 0u;
#pragma unroll
        for (unsigned j = 0; j < 16; ++j) { const unsigned c = xb_ld(&bar[XB_XCNT(j)]); sum += c; cnt += (c > 0u) ? 1u : 0u; mine = (j == x) ? c : mine; }
        if (sum == G) break;
        __builtin_amdgcn_s_sleep(1);
        if ((++sp & 255u) == 0u) { if (xb_ld(&bar[XB_TMO])) break; if (sp > XB_SPIN_CAP) { atomicAdd(&bar[XB_TMO], 1u); break; } }
    }
    nloc = mine > 0u ? mine : 1u; nx = cnt > 0u ? cnt : 1u;
}
__device__ __forceinline__ void xcd_barrier(unsigned* bar, unsigned x, volatile LAS unsigned* st) {
    asm volatile("s_waitcnt vmcnt(0)" ::: "memory");
    __syncthreads();
    if (threadIdx.x == 0) {
        __builtin_amdgcn_s_waitcnt(0);
        unsigned nloc = st[0], nx = st[1];
        if (nloc == 0u) { xcd_barrier_complete(bar, x, nloc, nx); st[0] = nloc; st[1] = nx; }
        const unsigned old = xb_add(&bar[XB_XSUB(x)], 1u);
        const unsigned gen = old / nloc;
        if (old + 1u == (gen + 1u) * nloc) {
            __builtin_amdgcn_fence(__ATOMIC_RELEASE, "agent");
            asm volatile("s_waitcnt vmcnt(0)" ::: "memory");
            const unsigned og = xb_add(&bar[XB_TOP], 1u);
            const unsigned tg = og / nx;
            if (og + 1u == (tg + 1u) * nx) xb_add(&bar[XB_TOPGEN], 1u);
            else XB_SPIN(xb_ld(&bar[XB_TOPGEN]) == tg, bar);
            __builtin_amdgcn_fence(__ATOMIC_ACQUIRE, "agent");
            xb_add(&bar[XB_XGEN(x)], 1u);
            asm volatile("s_waitcnt vmcnt(0)" ::: "memory");
        } else {
            XB_SPIN(xb_ld(&bar[XB_XGEN(x)]) == gen, bar);
            __builtin_amdgcn_fence(__ATOMIC_ACQUIRE, "agent");
            asm volatile("s_waitcnt vmcnt(0)" ::: "memory");
        }
    }
    __syncthreads();
}
#define GRID_BARRIER(wsptr) xcd_barrier((unsigned*)((wsptr) + WS_BAR), xcc_id, (volatile LAS unsigned*)(L + LDS_BYTES - 64))
constexpr int PH_PER_LAYER = 19, N_PHASES = 2 + 4 * PH_PER_LAYER;
__global__ void __launch_bounds__(512, 2) mega(Params Pk) {
  extern __shared__ __attribute__((aligned(16))) unsigned char lds_raw[];
  cg::grid_group grid = cg::this_grid();
  LAS unsigned char* L = (LAS unsigned char*)lds_raw;
  const int G = gridDim.x;
  const int ph_lo = Pk.ph_lo, ph_hi = Pk.ph_hi;
  if (ph_lo < 0) grid.sync();
  const unsigned xcc_id = xb_xcc_id();
  if (threadIdx.x < 16) ((volatile LAS unsigned*)(L + LDS_BYTES - 64))[threadIdx.x] = 0u;
  if (threadIdx.x == 0) (void)xb_add(&((unsigned*)(Pk.ws + WS_BAR))[XB_XCNT(xcc_id)], 1u);
  __syncthreads();
#ifdef TPROBE
  unsigned long long tacc = 0;
#endif
#pragma unroll 1
  for (int ph = ph_lo; ph < ph_hi; ++ph) {
#if defined(__HIP_DEVICE_COMPILE__)
    const __attribute__((address_space(4))) Params* pp = (const __attribute__((address_space(4))) Params*)__builtin_amdgcn_kernarg_segment_ptr();
    asm volatile("" : "+s"(pp));
    const Params P = *pp;
#else
    const Params P = Pk;
#endif
    bf16_t* Wb = (bf16_t*)(P.ws + WS_W); bf16_t* XN = (bf16_t*)(P.ws + WS_XN); unsigned char* SB = P.ws + WS_S;
    bf16_t* H = (bf16_t*)P.out;
#ifdef TPROBE
    int cls_op = 100, cls_p = 0, cls_ret = 0; const unsigned long long tp0 = __builtin_amdgcn_s_memrealtime();
#endif
    if (ph == 0) {
      prep_layer((float*)lds_raw, P, 0); build_tables(P); rows_norm(0, P, P.norm_g, nullptr);
    } else if (ph == N_PHASES - 1) {
      copy_out(P);
    } else {
      const int layer = (ph - 1) / PH_PER_LAYER, p = (ph - 1) % PH_PER_LAYER, j = layer >> 1; const bool is_ret = layer & 1;
      const float* ng = P.norm_g + layer * 4 * DM;
      int op = 0, grp = 0, s = 0;
      if (p == 0 || p == 16) { op = 0; s = (p == 16); }
      else if (p == 1 || p == 17) { op = 1; s = (p == 17); }
      else if (p == 2 || p == 15) op = 2;
      else if (p == 18) op = 3;
      else if (!is_ret) {
        if (p == 3) op = 4; else if (p == 4) op = 5; else if (p == 14) op = 1;
        else { grp = (p - 5) / 3; const int sub = (p - 5) % 3; op = sub == 0 ? 4 : (sub == 1 ? 6 : 7); }
      } else { grp = (p - 3) / 4; const int sub = (p - 3) % 4; op = sub == 0 ? 8 : (sub == 1 ? 9 : (sub == 2 ? 10 : 1)); }
      const int seqlen = grp == 0 ? 4096 : 8192, nseq = grp == 0 ? 4 : 2;
#ifdef TPROBE
      cls_op = op; cls_p = p; cls_ret = is_ret;
#endif

      if (op == 0) {
        pg8::Gemm g{XN, Wb + (s ? WE_GU1 : WE_GU0), T_ALL, 2 * FF, DM, DM}; pg8::StaticOrder S; S.init(T_ALL, 2 * FF, G, blockIdx.x);
        pg8::EpiSwiGLU E{(bf16_t*)(SB + S_ACT)};
#ifndef REP_FFNUP
#define REP_FFNUP 1
#endif
#pragma unroll 1
        for (int rep = 0; rep < REP_FFNUP; ++rep) pg8::gemm_phase(L, g, S, E);
      } else if (op == 1) {
        pg8::Gemm g; bf16_t* Hh = H; float alpha = 0.5f;
        if (p == 1 || p == 17) g = pg8::Gemm{(const bf16_t*)(SB + S_ACT), Wb + (s ? WE_D1 : WE_D0), T_ALL, DM, FF, FF};
        else if (!is_ret) { g = pg8::Gemm{XN, Wb + WE_MO, T_ALL, DM, DM, DM}; alpha = 1.f; }
        else { g = pg8::Gemm{(const bf16_t*)(SB + S_RQ), Wb + WE_RO, T_GRP, DM, 2048, 2048}; alpha = 1.f; Hh = H + (size_t)grp * T_GRP * DM; }
        pg8::StaticOrder S; S.init(g.M, DM, G, blockIdx.x);
#ifndef REP_RESID
#define REP_RESID 1
#endif
#pragma unroll 1
        for (int rep = 0; rep < REP_RESID; ++rep) { pg8::EpiResid E{Hh, (rep == REP_RESID - 1) ? alpha : 0.f}; pg8::gemm_phase(L, g, S, E); }
      } else if (op == 2) {
#ifndef REP_NORM
#define REP_NORM 1
#endif
        for (int rn_ = 0; rn_ < REP_NORM; ++rn_) rows_norm(1, P, ng + (p == 2 ? 1 : 2) * DM, nullptr);
      } else if (op == 3) {
#ifndef REP_PREP
#define REP_PREP 1
#endif
        for (int rep = 0; rep < REP_PREP; ++rep) if (layer < 3) prep_layer((float*)lds_raw, P, layer + 1);
        rows_norm(layer < 3 ? 2 : 3, P, ng + 3 * DM, layer < 3 ? ng + 4 * DM : nullptr);
      } else if (op == 4) {
        const int ng2 = (p == 3) ? 1 : 2;
#pragma unroll 1
#ifndef REP_BF16
#define REP_BF16 1
#endif
        for (int gi = 0; gi < ng2 * REP_BF16; ++gi) {
          pg8::Gemm g; pg8::EpiBf16 E;
          if (p == 3) { g = pg8::Gemm{XN, Wb + WE_DQKV, T_ALL, 768, DM, DM}; E = pg8::EpiBf16{(bf16_t*)(SB + S_CQKV), 768}; }
          else if ((gi & 1) == 0) { g = pg8::Gemm{(const bf16_t*)(SB + S_CQKV) + (size_t)grp * T_GRP * 768, Wb + WE_UQ, T_GRP, 1536, 384, 768}; E = pg8::EpiBf16{(bf16_t*)(SB + S_Q), 1536}; }
          else { g = pg8::Gemm{(const bf16_t*)(SB + S_CQKV) + (size_t)grp * T_GRP * 768 + 384, Wb + WE_UKV, T_GRP, 2048, 256, 768}; E = pg8::EpiBf16{(bf16_t*)(SB + S_KV), 2048}; }
          pg8::StaticOrder S; S.init(g.M, g.N, G, blockIdx.x);
          pg8::gemm_phase(L, g, S, E);
        }
      } else if (op == 5) {
        rows_mla_a(P, j);
      } else if (op == 6) {
        rows_mla_b(P, j, grp);
      } else if (op == 7) {
        const int nqb = seqlen >> 8; const int nunits = nseq * 8 * nqb;
        const bf16_t* Qg = (const bf16_t*)(SB + S_Q); const bf16_t* KVg = (const bf16_t*)(SB + S_KV); const bf16_t* KPE = (const bf16_t*)(SB + S_KPE);
#ifndef REP_ATTN
#define REP_ATTN 1
#endif
#pragma unroll 1
        for (int rep = 0; rep < REP_ATTN; ++rep)
#pragma unroll 1
        for (int u = blockIdx.x; u < nunits; u += G) {
          int qb = u % nqb, pr = u / nqb;
          if (G == 256) {
            const int rnd = u >> 8, bb = u & 255, xx = bb & 7, vb = bb >> 3;
            if (nqb == 32) { pr = rnd * 8 + xx; qb = vb; } else { pr = rnd * 16 + xx * 2 + (vb >> 4); qb = vb & 15; }
          }
          const int hd = pr & 7, sq = pr >> 3;
          const size_t r0 = (size_t)sq * seqlen;
          att::attn_unit(Qg + (r0 + (size_t)qb * 256) * 1536 + hd * 192, KVg + r0 * 2048 + hd * 256, KPE + r0 * 512 + hd * 64,
                         XN + ((size_t)grp * T_GRP + r0 + (size_t)qb * 256) * DM + hd * 128, seqlen, (char*)lds_raw, (int)(uintptr_t)L);
        }
      } else if (op == 8) {
        const float* c256 = (const float*)(P.ws + WS_TAB) + 2 * 8192 * 32;
        pg8::Gemm g{XN + (size_t)grp * T_GRP * DM, Wb + WE_RIN, T_GRP, 6144, DM, DM}; pg8::StaticOrder S; S.init(T_GRP, 6144, G, blockIdx.x);
        pg8::EpiRet E{(bf16_t*)(SB + S_RQ), (bf16_t*)(SB + S_RK), (bf16_t*)(SB + S_RKT), (bf16_t*)(SB + S_RV), (bf16_t*)(SB + S_RG), c256, c256 + 8192 * 128, seqlen - 1};
#ifndef REP_RETPROJ
#define REP_RETPROJ 1
#endif
#pragma unroll 1
        for (int rep = 0; rep < REP_RETPROJ; ++rep) pg8::gemm_phase(L, g, S, E);
      } else if (op == 9) {
        bf16_t* Pg = (bf16_t*)(P.ws + WS_P);
#define LG2_OF(dec_) ({ const float xg_ = __builtin_amdgcn_exp2f((dec_) * 1.4426950408889634f); \
          const float ser_ = xg_ * (1.f + xg_ * (0.5f + xg_ * (0.33333334f + xg_ * (0.25f + xg_ * (0.2f + xg_ * (0.16666667f + xg_ * (0.14285715f + xg_ * 0.125f))))))); -ser_ * 1.4426950408889634f; })
#pragma unroll 1
        for (int u = blockIdx.x; u < (T_GRP / 64) * 4; u += G) {
          const int hd = u & 3, c = u >> 2;
          ret::p_unit(L, (const bf16_t*)(SB + S_RQ), (const bf16_t*)(SB + S_RK), (bf16_t*)(SB + S_RKT), Pg, c, hd, LG2_OF(P.r_df[j * 4 + hd]), LG2_OF(P.r_db[j * 4 + hd]));
        }
        GRID_BARRIER(P.ws);
        const int nitems = nseq * 4 * 2 * 16;
#ifndef REP_SCAN
#define REP_SCAN 1
#endif
#pragma unroll 1
        for (int rep = 0; rep < REP_SCAN; ++rep)
#pragma unroll 1
        for (int itx = blockIdx.x; itx < nitems; itx += G) {
          int sl = itx & 15, combo = itx >> 4;
          if (G == 256) {
            const int rnd = itx >> 8, bb = itx & 255, xx = bb & 7, vb = bb >> 3;
            sl = vb & 15; combo = rnd * 16 + xx * 2 + (vb >> 4);
          }
          const int dir = combo & 1, hd = (combo >> 1) & 3, sq = combo >> 3;
          const float lg2 = LG2_OF((dir ? P.r_db : P.r_df)[j * 4 + hd]);
          ret::scan_item(L, (const bf16_t*)(SB + S_RQ), (const bf16_t*)(SB + S_RKT), (const bf16_t*)(SB + S_RV), Pg,
                         (bf16_t*)(SB + (dir ? S_OB : S_OF)), seqlen, sq, hd, dir, sl, lg2);
        }
      } else if (op == 10) {
#ifndef REP_GN
#define REP_GN 1
#endif
        for (int rep = 0; rep < REP_GN; ++rep) rows_ret_gn(P, j);
      }
    }
#ifndef REP_BAR
#define REP_BAR 1
#endif
#ifdef TPROBE
    GRID_BARRIER(P.ws);
    { const int op = cls_op, p = cls_p, is_ret = cls_ret; (void)op; (void)p; (void)is_ret; if (TPROBE) tacc += __builtin_amdgcn_s_memrealtime() - tp0; }
#else
    if (ph + 1 < ph_hi) { for (int rb_ = 0; rb_ < REP_BAR; ++rb_) GRID_BARRIER(P.ws); }
#endif
  }
#ifdef TPROBE
  {
#ifndef TSCALE
#define TSCALE 50.f
#endif
    unsigned char* wsb = Pk.ws; unsigned* cnt = (unsigned*)(wsb + WS_BAR) + 3520;
    if (blockIdx.x == 0 && threadIdx.x == 0) __hip_atomic_store(cnt, (unsigned)(tacc / 100ull), __ATOMIC_RELAXED, __HIP_MEMORY_SCOPE_AGENT);
    GRID_BARRIER(wsb);
    const unsigned us = __hip_atomic_load(cnt, __ATOMIC_RELAXED, __HIP_MEMORY_SCOPE_AGENT);
    const float v = 10.f + (float)us / TSCALE;
    for (size_t i = (size_t)blockIdx.x * 512 + threadIdx.x; i < (size_t)T_ALL * DM; i += (size_t)G * 512) Pk.out[i] = v;
  }
#endif
#ifdef DBG_N
  {
    unsigned char* wsb = Pk.ws; float* Hh = Pk.out; const unsigned* XNw = (const unsigned*)(wsb + WS_XN);
    GRID_BARRIER(wsb);
    unsigned hsh = 0, nanc = 0; const size_t nth = (size_t)G * 512, gt = (size_t)blockIdx.x * 512 + threadIdx.x;
#if DBG_WHAT & 1
    for (size_t i = gt; i < (size_t)T_ALL * DM; i += nth) { const unsigned u = __float_as_uint(Hh[i]); hsh += u * 2654435761u + 1u; if ((u & 0x7f800000u) == 0x7f800000u) ++nanc; }
#endif
#if DBG_WHAT & 2
    for (size_t i = gt; i < (size_t)T_ALL * DM / 2; i += nth) { const unsigned u = XNw[i]; hsh += u * 2246822519u + 1u; if ((u & 0x7f800000u) == 0x7f800000u || (u & 0x7f80u) == 0x7f80u) ++nanc; }
#endif
#if DBG_WHAT & 4
    { const unsigned* Sw = (const unsigned*)(wsb + WS_S + DBG_OFF); for (size_t i = gt; i < (size_t)DBG_LEN / 4; i += nth) { const unsigned u = Sw[i]; hsh += u * 3266489917u + 1u; if ((u & 0x7f800000u) == 0x7f800000u || (u & 0x7f80u) == 0x7f80u) ++nanc; } }
#endif
    unsigned* cnt = (unsigned*)(wsb + WS_BAR) + 3520;
    atomicAdd(cnt, hsh); atomicAdd(cnt + 1, nanc);
    GRID_BARRIER(wsb);
    const unsigned th = __hip_atomic_load(cnt, __ATOMIC_RELAXED, __HIP_MEMORY_SCOPE_AGENT), tn = __hip_atomic_load(cnt + 1, __ATOMIC_RELAXED, __HIP_MEMORY_SCOPE_AGENT);
    const float v = (tn ? 30.f : 10.f) + (float)(th & 1023u) * 1e-3f;
    for (size_t i = gt; i < (size_t)T_ALL * DM; i += nth) Hh[i] = v;
  }
#endif
}

extern "C" void kernel_launch(void* const* d_in, const int* in_sizes, int n_in, void* d_out, int out_size, void* d_ws, size_t ws_size, hipStream_t stream) {
  static int grid_blocks = 0;
  if (grid_blocks == 0) {
    if (n_in != 20 || out_size != T_ALL * DM || ws_size < WS_END) { fprintf(stderr, "kernel_launch: unexpected shapes n_in %d out %d ws %zu (need %zu)\n", n_in, out_size, ws_size, (size_t)WS_END); }
    int dev = 0, cus = 0, per_cu = 0;
    (void)hipGetDevice(&dev);
    (void)hipDeviceGetAttribute(&cus, hipDeviceAttributeMultiprocessorCount, dev);
    if (hipFuncSetAttribute((const void*)mega, hipFuncAttributeMaxDynamicSharedMemorySize, LDS_BYTES) != hipSuccess) fprintf(stderr, "kernel_launch: hipFuncSetAttribute failed\n");
    if (hipOccupancyMaxActiveBlocksPerMultiprocessor(&per_cu, (const void*)mega, 512, LDS_BYTES) != hipSuccess || per_cu < 1) { fprintf(stderr, "kernel_launch: occupancy query gave %d\n", per_cu); per_cu = 1; }
    (void)hipGetLastError();
    grid_blocks = cus * per_cu;
  }
  Params p{};
  p.xp = (const float*)d_in[0]; p.xs = (const float*)d_in[1]; p.norm_g = (const float*)d_in[2]; p.ffn_g = (const float*)d_in[3]; p.ffn_u = (const float*)d_in[4]; p.ffn_d = (const float*)d_in[5];
  p.m_dq = (const float*)d_in[6]; p.m_qa = (const float*)d_in[7]; p.m_uq = (const float*)d_in[8]; p.m_dkv = (const float*)d_in[9]; p.m_kva = (const float*)d_in[10]; p.m_ukv = (const float*)d_in[11];
  p.m_qn = (const float*)d_in[12]; p.m_kn = (const float*)d_in[13]; p.m_wo = (const float*)d_in[14];
  p.r_in = (const float*)d_in[15]; p.r_df = (const float*)d_in[16]; p.r_db = (const float*)d_in[17]; p.r_gn = (const float*)d_in[18]; p.r_wo = (const float*)d_in[19];
  p.out = (float*)d_out; p.ws = (unsigned char*)d_ws; p.ph_lo = 0; p.ph_hi = N_PHASES;
#ifdef DBG_N
  p.ph_hi = DBG_N;
#endif
  (void)hipMemsetAsync((char*)d_ws + WS_BAR, 0, 16384, stream);
  void* args[] = {&p};
  hipError_t e = hipLaunchCooperativeKernel((const void*)mega, dim3(grid_blocks), dim3(512), args, LDS_BYTES, stream);
  if (e != hipSuccess) fprintf(stderr, "kernel_launch: cooperative launch failed: %s (grid %d)\n", hipGetErrorString(e), grid_blocks);
}
```

```cpp
#include <hip/hip_runtime.h>
#include <hip/hip_cooperative_groups.h>
#include <cstdio>
#include <cstdint>
#include <cmath>
namespace cg = cooperative_groups;

#define LAS __attribute__((address_space(3)))
typedef unsigned short bf16_t;
typedef short bf16x8 __attribute__((ext_vector_type(8)));
typedef short s16x4 __attribute__((ext_vector_type(4)));
typedef float f32x4 __attribute__((ext_vector_type(4)));
typedef float f32x16 __attribute__((ext_vector_type(16)));
typedef unsigned u32x4 __attribute__((ext_vector_type(4)));
typedef unsigned u32x2 __attribute__((ext_vector_type(2)));

constexpr int T_ALL = 49152, T_GRP = 16384, DM = 1024, FF = 2816;
constexpr float EPS = 1e-6f;
constexpr int LDS_BYTES = 147456;
constexpr size_t MiB = 1u << 20;
constexpr size_t WS_W = 0;
constexpr size_t WS_TAB = 56 * MiB;
constexpr size_t WS_XN = 66 * MiB;
constexpr size_t WS_S = 162 * MiB;
constexpr size_t WS_BAR = WS_S + 352 * MiB;
constexpr size_t WS_P = WS_BAR + 16384;
constexpr size_t WS_END = WS_P + 16 * MiB;
constexpr size_t WE_GU0 = 0, WE_D0 = WE_GU0 + (size_t)5632 * 1024, WE_GU1 = WE_D0 + (size_t)1024 * 2816, WE_D1 = WE_GU1 + (size_t)5632 * 1024,
                 WE_MIX = WE_D1 + (size_t)1024 * 2816;
constexpr size_t WE_DQKV = WE_MIX, WE_UQ = WE_DQKV + (size_t)768 * 1024, WE_UKV = WE_UQ + (size_t)1536 * 384, WE_MO = WE_UKV + (size_t)2048 * 256;
constexpr size_t WE_RIN = WE_MIX, WE_RO = WE_RIN + (size_t)6144 * 1024;
constexpr size_t S_ACT = 0;
constexpr size_t S_CQKV = 0, S_Q = 72 * MiB, S_KV = 120 * MiB, S_KPE = 184 * MiB;
constexpr size_t S_RQ = 0, S_RK = 32 * MiB, S_RKT = 64 * MiB, S_RV = 96 * MiB, S_RG = 160 * MiB, S_OF = 224 * MiB, S_OB = 288 * MiB;

struct Params {
  const float* xp; const float* xs; const float* norm_g; const float* ffn_g; const float* ffn_u; const float* ffn_d;
  const float* m_dq; const float* m_qa; const float* m_uq; const float* m_dkv; const float* m_kva; const float* m_ukv;
  const float* m_qn; const float* m_kn; const float* m_wo;
  const float* r_in; const float* r_df; const float* r_db; const float* r_gn; const float* r_wo;
  float* out; unsigned char* ws;
  int ph_lo, ph_hi;
};

typedef __bf16 bf16x2_t __attribute__((ext_vector_type(2)));
typedef float f32x2_t __attribute__((ext_vector_type(2)));
__device__ __forceinline__ unsigned cvt_pk_bf16(float lo, float hi) { const f32x2_t v = {lo, hi}; const bf16x2_t b = __builtin_convertvector(v, bf16x2_t); return __builtin_bit_cast(unsigned, b); }
__device__ __forceinline__ float bflo(unsigned w) { return __uint_as_float(w << 16); }
__device__ __forceinline__ float bfhi(unsigned w) { return __uint_as_float(w & 0xffff0000u); }
__device__ __forceinline__ float bf2f(unsigned short u) { return __uint_as_float(((unsigned)u) << 16); }
__device__ __forceinline__ unsigned short f2bf(float f) { return (unsigned short)(cvt_pk_bf16(f, 0.f) & 0xffffu); }
__device__ __forceinline__ float wave_sum(float v) {
#pragma unroll
  for (int o = 32; o > 0; o >>= 1) v += __shfl_xor(v, o);
  return v;
}
__device__ __forceinline__ int tidx() { int t = threadIdx.x; asm volatile("" : "+v"(t)); return t; }
__device__ __forceinline__ float silu_f(float x) { return x * __builtin_amdgcn_rcpf(1.f + __builtin_amdgcn_exp2f(-1.4426950408889634f * x)); }

namespace pg8 {
constexpr int BM = 256, BK = 64, HALF = 128, HTB = HALF * BK * 2, NXCD = 8, WGM = 8;
__host__ __device__ __forceinline__ int lds_byte(int r, int c) { const int st = (r >> 4) * 2 + (c >> 5), rr = r & 15, cc = c & 31, ob = rr * 64 + cc * 2; return st * 1024 + (ob ^ (((ob >> 9) & 1) << 5)); }
__host__ __device__ __forceinline__ void stage_rc(int b, int& R, int& C) { const int st = b / 1024, sb = b % 1024, swz = sb ^ (((sb >> 9) & 1) << 5); R = (st >> 1) * 16 + swz / 64; C = (st & 1) * 32 + (swz % 64) / 2; }
__host__ __device__ __forceinline__ int perm32(int rho) { const int n = rho >> 4, i = rho & 15; return 8 * (i >> 2) + 4 * n + (i & 3); }
struct Unit { int pm, pn; };
struct Gemm { const bf16_t* A; const bf16_t* Bt; int M, N, K, lda; };
struct StaticOrder {
  int nM, nN, nwg, G, c;
  __device__ void init(int M, int N, int G_, int c_) { nM = M / BM; nN = N / BM; nwg = nM * nN; G = G_; c = c_; }
  __device__ bool next(int i, Unit& u) const {
    const long L = (long)i * G + c; if (L >= nwg) return false;
    int wgid = (int)L; { const int q = nwg / NXCD, r = nwg % NXCD, xcd = wgid % NXCD, off = wgid / NXCD; wgid = (xcd < r ? xcd * (q + 1) : r * (q + 1) + (xcd - r) * q) + off; }
    const int nig = WGM * nN, gid = wgid / nig, fm = gid * WGM, gsz = (nM - fm) < WGM ? (nM - fm) : WGM;
    u.pm = fm + ((wgid % nig) % gsz); u.pn = (wgid % nig) / gsz; return true;
  }
};
template <class Epi>
__device__ __forceinline__ void gemm_phase(LAS unsigned char* lds, const Gemm g, const StaticOrder& S, const Epi& E) {
  const int tid = tidx(), wid = __builtin_amdgcn_readfirstlane(tid >> 6), lane = tid & 63, wr = wid >> 2, wc = wid & 3, fr = lane & 15, fq = lane >> 4;
  const int K = g.K, nt = K / BK, lda = g.lda;
  unsigned voffA[2], voffB[2];
#pragma unroll
  for (int i = 0; i < 2; ++i) { int R, C; stage_rc(tid * 16 + i * 8192, R, C); const int Rb = (R & ~31) + perm32(R & 31);
    voffA[i] = (unsigned)(R * lda + C) * 2u; voffB[i] = (unsigned)(i * 8192 + tid * 16); (void)Rb; }
  const size_t kstep = (size_t)(BK * 2), kstepB = 16384;
  const size_t hstepA = (size_t)HALF * lda * 2, hstepB = (size_t)nt * 16384;
  const size_t tstepA = 2 * hstepA, tstepB = 2 * hstepB;
  const unsigned ldsw = (unsigned)wid * 1024u;
  const int aoff = lds_byte(wr * 64 + fr, fq * 8), boff = lds_byte(wc * 32 + fr, fq * 8);
#define PG8_SA(b, h) (((b) * 2 + (h)) * HTB)
#define PG8_SB(b, h) ((4 + (b) * 2 + (h)) * HTB)
#define PG8_STAGE(bufoff, gbase, voff) do { _Pragma("unroll") for (int _i = 0; _i < 2; ++_i) \
    __builtin_amdgcn_global_load_lds((const unsigned*)((const char*)(gbase) + (voff)[_i]), (LAS unsigned*)(lds + (bufoff) + ldsw + _i * 8192), 16, 0, 0); } while (0)
#define PG8_LDA(dst, b, h) do { _Pragma("unroll") for (int m = 0; m < 4; ++m) _Pragma("unroll") for (int k = 0; k < 2; ++k) dst[m][k] = *(const LAS bf16x8*)(lds + PG8_SA(b, h) + aoff + m * 2048 + k * 1024); } while (0)
#define PG8_LDB(dst, b, h) do { _Pragma("unroll") for (int n = 0; n < 2; ++n) _Pragma("unroll") for (int k = 0; k < 2; ++k) dst[n][k] = *(const LAS bf16x8*)(lds + PG8_SB(b, h) + boff + n * 2048 + k * 1024); } while (0)
#define PG8_MMA(ai, bj, At, Bt) do { __builtin_amdgcn_s_setprio(1); _Pragma("unroll") for (int m = 0; m < 4; ++m) _Pragma("unroll") for (int n = 0; n < 2; ++n) _Pragma("unroll") for (int k = 0; k < 2; ++k) \
    acc[ai][bj][m][n] = __builtin_amdgcn_mfma_f32_16x16x32_bf16(Bt[n][k], At[m][k], acc[ai][bj][m][n], 0, 0, 0); __builtin_amdgcn_s_setprio(0); } while (0)
#define PG8_WAIT_V(n) asm volatile("s_waitcnt vmcnt(" #n ")" ::: "memory")
#define PG8_WAIT_L(n) asm volatile("s_waitcnt lgkmcnt(" #n ")" ::: "memory")
#define PG8_BAR __builtin_amdgcn_s_barrier()
#define PG8_SCHED __builtin_amdgcn_sched_barrier(0)
  Unit cur, nxt; int ui = 0;
  if (!S.next(0, cur)) return;
  f32x4 acc[2][2][4][2];
#pragma unroll
  for (int a = 0; a < 2; ++a)
#pragma unroll
    for (int b = 0; b < 2; ++b)
#pragma unroll
      for (int m = 0; m < 4; ++m)
#pragma unroll
        for (int n = 0; n < 2; ++n) acc[a][b][m][n] = (f32x4){0.f, 0.f, 0.f, 0.f};
  bf16x8 At[4][2], B0[2][2], B1[2][2];
  const char* cA = (const char*)g.A + (size_t)cur.pm * tstepA; const char* cB = (const char*)g.Bt + (size_t)cur.pn * tstepB;
  PG8_STAGE(PG8_SB(0, 0), cB, voffB); PG8_STAGE(PG8_SB(0, 1), cB + hstepB, voffB); PG8_STAGE(PG8_SA(0, 0), cA, voffA); PG8_STAGE(PG8_SA(0, 1), cA + hstepA, voffA);
  if (wr == 1) PG8_BAR;
  PG8_WAIT_V(2); PG8_BAR;
  PG8_STAGE(PG8_SB(1, 0), cB + kstepB, voffB); PG8_STAGE(PG8_SA(1, 0), cA + kstep, voffA); PG8_STAGE(PG8_SB(1, 1), cB + hstepB + kstepB, voffB);
  PG8_WAIT_V(6); PG8_BAR;
  for (;;) {
    const bool has_next = S.next(ui + 1, nxt);
    const char* nA = has_next ? (const char*)g.A + (size_t)nxt.pm * tstepA : cA; const char* nB = has_next ? (const char*)g.Bt + (size_t)nxt.pn * tstepB : cB;
    for (int t = 0; t < nt; t += 2) {
      const bool last = (t == nt - 2);
      const char* a1 = cA + (size_t)(t + 1) * kstep;
      const char* a2 = last ? nA : cA + (size_t)(t + 2) * kstep; const char* b2 = last ? nB : cB + (size_t)(t + 2) * kstepB;
      const char* a3 = a2 + kstep; const char* b3 = b2 + kstepB;
      PG8_LDB(B0, 0, 0); PG8_LDB(B1, 0, 1); PG8_SCHED; PG8_LDA(At, 0, 0); PG8_STAGE(PG8_SA(1, 1), a1 + hstepA, voffA);
      PG8_WAIT_V(8); PG8_WAIT_L(0); PG8_BAR; PG8_MMA(0, 0, At, B0); PG8_MMA(0, 1, At, B1); PG8_BAR; PG8_SCHED;
      PG8_LDA(At, 0, 1); PG8_STAGE(PG8_SB(0, 0), b2, voffB); PG8_STAGE(PG8_SB(0, 1), b2 + hstepB, voffB); PG8_STAGE(PG8_SA(0, 0), a2, voffA);
      PG8_WAIT_V(8); PG8_WAIT_L(0); PG8_BAR; PG8_MMA(1, 0, At, B0); PG8_MMA(1, 1, At, B1); PG8_BAR; PG8_SCHED;
      PG8_LDB(B0, 1, 0); PG8_LDB(B1, 1, 1); PG8_SCHED; PG8_LDA(At, 1, 0); PG8_STAGE(PG8_SA(0, 1), a2 + hstepA, voffA);
      PG8_WAIT_V(8); PG8_WAIT_L(0); PG8_BAR; PG8_MMA(0, 0, At, B0); PG8_MMA(0, 1, At, B1); PG8_BAR; PG8_SCHED;
      PG8_LDA(At, 1, 1); PG8_STAGE(PG8_SB(1, 0), b3, voffB); PG8_STAGE(PG8_SB(1, 1), b3 + hstepB, voffB); PG8_STAGE(PG8_SA(1, 0), a3, voffA);
      PG8_WAIT_V(8); PG8_WAIT_L(0); PG8_BAR; PG8_MMA(1, 0, At, B0); PG8_MMA(1, 1, At, B1); PG8_BAR; PG8_SCHED;
    }
    if (wr == 0) PG8_BAR;
    E(acc, cur, wr, wc, fr, fq);
    if (!has_next) break;
#pragma unroll
    for (int a = 0; a < 2; ++a)
#pragma unroll
      for (int b = 0; b < 2; ++b)
#pragma unroll
        for (int m = 0; m < 4; ++m)
#pragma unroll
          for (int n = 0; n < 2; ++n) acc[a][b][m][n] = (f32x4){0.f, 0.f, 0.f, 0.f};
    cur = nxt; cA = nA; cB = nB; ++ui;
    if (wr == 1) PG8_BAR;
  }
  PG8_WAIT_V(0);
  PG8_BAR;
#undef PG8_SA
#undef PG8_SB
#undef PG8_STAGE
#undef PG8_LDA
#undef PG8_LDB
#undef PG8_MMA
#undef PG8_WAIT_V
#undef PG8_WAIT_L
#undef PG8_BAR
#undef PG8_SCHED
}

struct EpiBf16 {
  bf16_t* O; int ldc;
  __device__ __forceinline__ void operator()(const f32x4 (&acc)[2][2][4][2], const Unit& u, int wr, int wc, int fr, int fq) const {
    const int row0 = u.pm * BM + wr * 64 + fr, col0 = u.pn * BM + wc * 32 + 8 * fq;
#pragma unroll
    for (int ai = 0; ai < 2; ++ai)
#pragma unroll
      for (int m = 0; m < 4; ++m) { bf16_t* rowp = O + (size_t)(row0 + ai * HALF + m * 16) * ldc + col0;
#pragma unroll
        for (int bj = 0; bj < 2; ++bj) { const f32x4 v0 = acc[ai][bj][m][0], v1 = acc[ai][bj][m][1];
          u32x4 w; w.x = cvt_pk_bf16(v0[0], v0[1]); w.y = cvt_pk_bf16(v0[2], v0[3]); w.z = cvt_pk_bf16(v1[0], v1[1]); w.w = cvt_pk_bf16(v1[2], v1[3]);
          *(u32x4*)(rowp + bj * HALF) = w; } }
  }
};
struct EpiSwiGLU {
  bf16_t* O;
  __device__ __forceinline__ void operator()(const f32x4 (&acc)[2][2][4][2], const Unit& u, int wr, int wc, int fr, int fq) const {
    const int row0 = u.pm * BM + wr * 64 + fr, col0 = u.pn * 128 + wc * 32 + 8 * fq;
#pragma unroll
    for (int ai = 0; ai < 2; ++ai)
#pragma unroll
      for (int m = 0; m < 4; ++m) { bf16_t* rowp = O + (size_t)(row0 + ai * HALF + m * 16) * FF + col0;
        const f32x4 g0 = acc[ai][0][m][0], g1 = acc[ai][0][m][1], u0 = acc[ai][1][m][0], u1 = acc[ai][1][m][1];
        u32x4 w; w.x = cvt_pk_bf16(silu_f(g0[0]) * u0[0], silu_f(g0[1]) * u0[1]); w.y = cvt_pk_bf16(silu_f(g0[2]) * u0[2], silu_f(g0[3]) * u0[3]);
        w.z = cvt_pk_bf16(silu_f(g1[0]) * u1[0], silu_f(g1[1]) * u1[1]); w.w = cvt_pk_bf16(silu_f(g1[2]) * u1[2], silu_f(g1[3]) * u1[3]);
        *(u32x4*)rowp = w; }
  }
};
struct EpiResid {
  bf16_t* H; float alpha;
  __device__ __forceinline__ void operator()(const f32x4 (&acc)[2][2][4][2], const Unit& u, int wr, int wc, int fr, int fq) const {
    const int row0 = u.pm * BM + wr * 64 + fr, col0 = u.pn * BM + wc * 32 + 8 * fq;
#pragma unroll
    for (int ai = 0; ai < 2; ++ai)
#pragma unroll
      for (int m = 0; m < 4; ++m) { bf16_t* rowp = H + (size_t)(row0 + ai * HALF + m * 16) * DM + col0;
#pragma unroll
        for (int bj = 0; bj < 2; ++bj) { u32x4* p = (u32x4*)(rowp + bj * HALF); const u32x4 h = *p;
          const f32x4 a = acc[ai][bj][m][0] * alpha, b = acc[ai][bj][m][1] * alpha;
          u32x4 w; w.x = cvt_pk_bf16(bflo(h.x) + a[0], bfhi(h.x) + a[1]); w.y = cvt_pk_bf16(bflo(h.y) + a[2], bfhi(h.y) + a[3]);
          w.z = cvt_pk_bf16(bflo(h.z) + b[0], bfhi(h.z) + b[1]); w.w = cvt_pk_bf16(bflo(h.w) + b[2], bfhi(h.w) + b[3]);
          *p = w; } }
  }
};
struct EpiRet {
  bf16_t* RQ; bf16_t* RK; bf16_t* RKT; bf16_t* RV; bf16_t* RG; const float* ctab; const float* stab; int seqmask;
  __device__ __forceinline__ void operator()(const f32x4 (&acc)[2][2][4][2], const Unit& u, int wr, int wc, int fr, int fq) const {
    const int row0 = u.pm * BM + wr * 64 + fr; const int pn = u.pn; const int cin = wc * 32 + 8 * fq;
    if (pn < 8) {
      const bool isk = pn >= 4; const int head = pn & 3; const float sc = isk ? 0.0625f : 1.f;
      bf16_t* dst = isk ? RK : RQ;
#pragma unroll
      for (int ai = 0; ai < 2; ++ai)
#pragma unroll
        for (int m = 0; m < 4; ++m) { const int lr = row0 + ai * HALF + m * 16; const int pos = lr & seqmask;
          const float* cp = ctab + (size_t)pos * 128 + cin; const float* sp = stab + (size_t)pos * 128 + cin;
          float o1[8], o2[8];
#pragma unroll
          for (int n = 0; n < 2; ++n) { const f32x4 c4 = *(const f32x4*)(cp + 4 * n), s4 = *(const f32x4*)(sp + 4 * n); const f32x4 x1 = acc[ai][0][m][n], x2 = acc[ai][1][m][n];
#pragma unroll
            for (int j = 0; j < 4; ++j) { o1[4 * n + j] = (x1[j] * c4[j] - x2[j] * s4[j]) * sc; o2[4 * n + j] = (x2[j] * c4[j] + x1[j] * s4[j]) * sc; } }
          u32x4 w1, w2; w1.x = cvt_pk_bf16(o1[0], o1[1]); w1.y = cvt_pk_bf16(o1[2], o1[3]); w1.z = cvt_pk_bf16(o1[4], o1[5]); w1.w = cvt_pk_bf16(o1[6], o1[7]);
          w2.x = cvt_pk_bf16(o2[0], o2[1]); w2.y = cvt_pk_bf16(o2[2], o2[3]); w2.z = cvt_pk_bf16(o2[4], o2[5]); w2.w = cvt_pk_bf16(o2[6], o2[7]);
          if (isk) { bf16_t* rp = dst + (size_t)lr * 1024 + head * 256 + cin; *(u32x4*)rp = w1; *(u32x4*)(rp + 128) = w2; }
          else {
            bf16_t* qb = dst + ((size_t)((lr >> 6) * 4 + head) * 4 + m) * 4096 + (size_t)(fq * 16 + fr) * 8;
            *(u32x4*)(qb + wc * 512) = w1; *(u32x4*)(qb + (4 + wc) * 512) = w2; }
        }
    } else {
      const bool isg = pn >= 16; bf16_t* dst = isg ? RG : RV; const int cbase = (isg ? pn - 16 : pn - 8) * 256 + cin;
#pragma unroll
      for (int ai = 0; ai < 2; ++ai)
#pragma unroll
        for (int m = 0; m < 4; ++m) { bf16_t* rowp = dst + (size_t)(row0 + ai * HALF + m * 16) * 2048 + cbase;
#pragma unroll
          for (int bj = 0; bj < 2; ++bj) { f32x4 v0 = acc[ai][bj][m][0], v1 = acc[ai][bj][m][1];
            if (isg) {
#pragma unroll
              for (int j = 0; j < 4; ++j) { v0[j] = silu_f(v0[j]); v1[j] = silu_f(v1[j]); } }
            u32x4 w; w.x = cvt_pk_bf16(v0[0], v0[1]); w.y = cvt_pk_bf16(v0[2], v0[3]); w.z = cvt_pk_bf16(v1[0], v1[1]); w.w = cvt_pk_bf16(v1[2], v1[3]);
            *(u32x4*)(rowp + bj * HALF) = w; } }
    }
  }
};
}

namespace att {
constexpr int KVBLK = 64;
constexpr float SCALE = 0.07216878364870323f;
constexpr float THR = 8.f;
constexpr int SHM_K = KVBLK * 192 * 2, SHM_V = KVBLK * 128 * 2;
#define KSWZ(row, colB) ((row) * 384 + ((colB) ^ (((row) & 7) << 4)))
#define SBAR() __builtin_amdgcn_sched_barrier(0)
__device__ __forceinline__ int crow(int r, int hi) { return (r & 3) + 8 * (r >> 2) + 4 * hi; }
__device__ __forceinline__ void partialSM(f32x16& p0, f32x16& p1, float& m_reg, float& mn, float& alpha) {
  constexpr float C = SCALE * 1.4426950408889634f;
  float pmax = p0[0];
#pragma unroll
  for (int r = 1; r < 16; ++r) pmax = fmaxf(pmax, p0[r]);
#pragma unroll
  for (int r = 0; r < 16; ++r) pmax = fmaxf(pmax, p1[r]);
  { auto rr = __builtin_amdgcn_permlane32_swap(__float_as_uint(pmax), __float_as_uint(pmax), false, false);
    pmax = fmaxf(__uint_as_float(rr[0]), __uint_as_float(rr[1])); }
  if (__builtin_expect(__all(pmax - m_reg <= THR / SCALE), 1)) { mn = m_reg; alpha = 1.f; }
  else { mn = fmaxf(m_reg, pmax); alpha = __builtin_amdgcn_exp2f((m_reg - mn) * C); m_reg = mn; }
  const float mnC = -mn * C;
#pragma unroll
  for (int r = 0; r < 16; ++r) p0[r] = __builtin_amdgcn_exp2f(fmaf(p0[r], C, mnC));
#pragma unroll
  for (int r = 0; r < 16; ++r) p1[r] = __builtin_amdgcn_exp2f(fmaf(p1[r], C, mnC));
}
__device__ __forceinline__ void finishSM(f32x16& p0, f32x16& p1, float alpha, float& l_reg, bf16x8& pa0, bf16x8& pa1, bf16x8& pa2, bf16x8& pa3) {
  float ps = 0;
#pragma unroll
  for (int r = 0; r < 16; ++r) ps += p0[r];
#pragma unroll
  for (int r = 0; r < 16; ++r) ps += p1[r];
  { auto rr = __builtin_amdgcn_permlane32_swap(__float_as_uint(ps), __float_as_uint(ps), false, false);
    ps = __uint_as_float(rr[0]) + __uint_as_float(rr[1]); }
  l_reg = l_reg * alpha + ps;
#define PK4(P, BASE, OUT) do { unsigned a0 = cvt_pk_bf16(P[BASE + 0], P[BASE + 1]), a1 = cvt_pk_bf16(P[BASE + 2], P[BASE + 3]);   \
    unsigned b0 = cvt_pk_bf16(P[BASE + 4], P[BASE + 5]), b1 = cvt_pk_bf16(P[BASE + 6], P[BASE + 7]);                              \
    auto r0 = __builtin_amdgcn_permlane32_swap(a0, b0, false, false); auto r1 = __builtin_amdgcn_permlane32_swap(a1, b1, false, false); \
    u32x4 w = {r0[0], r1[0], r0[1], r1[1]}; OUT = *reinterpret_cast<bf16x8*>(&w); } while (0)
  PK4(p0, 0, pa0); PK4(p0, 8, pa1); PK4(p1, 0, pa2); PK4(p1, 8, pa3);
#undef PK4
}
__device__ __forceinline__ void qkt(f32x16& p0, f32x16& p1, const char* Ks, const bf16x8* qr, int r32, int hi) {
  p0 = f32x16{}; p1 = f32x16{};
  bf16x8 k0[3], k1[3];
#define KLD(S, D0) do { const int cb = ((D0) * 16 + hi * 8) * 2; k0[S] = *reinterpret_cast<const bf16x8*>(Ks + KSWZ(r32, cb)); k1[S] = *reinterpret_cast<const bf16x8*>(Ks + KSWZ(32 + r32, cb)); } while (0)
  KLD(0, 0); KLD(1, 1);
#pragma unroll
  for (int d0 = 0; d0 < 12; ++d0) {
    if (d0 + 2 < 12) KLD((d0 + 2) % 3, d0 + 2);
    SBAR();
    p0 = __builtin_amdgcn_mfma_f32_32x32x16_bf16(k0[d0 % 3], qr[d0], p0, 0, 0, 0);
    p1 = __builtin_amdgcn_mfma_f32_32x32x16_bf16(k1[d0 % 3], qr[d0], p1, 0, 0, 0);
    SBAR();
  }
#undef KLD
}
__device__ __forceinline__ int v_st(int k, int c) { const int kk = (k & ~0xC) | ((k & 4) << 1) | ((k & 8) >> 1); return ((kk >> 3) * 4 + (c >> 5)) * 512 + ((kk & 7) * 32 + (c & 31)) * 2; }
__device__ __forceinline__ int v_rd_base(int lane) { return ((lane & 3) << 3) | (((lane >> 2) & 3) << 6) | (((lane >> 4) & 1) << 5) | (((lane >> 5) & 1) << 8); }
constexpr int v_rd_off(int d0, int ks, int half) { return d0 * 512 + ks * 4096 + half * 2048; }
template <int OFF> __device__ __forceinline__ s16x4 tr_read(int vb) {
  s16x4 r; asm volatile("ds_read_b64_tr_b16 %0, %1 offset:%2" : "=&v"(r) : "v"(vb), "i"(OFF) : "memory"); return r;
}
template <int D0> __device__ __forceinline__ void pv_reads(s16x4 (&r)[8], int vb) {
  r[0] = tr_read<v_rd_off(D0, 0, 0)>(vb); r[1] = tr_read<v_rd_off(D0, 0, 1)>(vb); r[2] = tr_read<v_rd_off(D0, 1, 0)>(vb); r[3] = tr_read<v_rd_off(D0, 1, 1)>(vb);
  r[4] = tr_read<v_rd_off(D0, 2, 0)>(vb); r[5] = tr_read<v_rd_off(D0, 2, 1)>(vb); r[6] = tr_read<v_rd_off(D0, 3, 0)>(vb); r[7] = tr_read<v_rd_off(D0, 3, 1)>(vb);
}
__device__ __forceinline__ void pv_mma(f32x16& od, const s16x4 (&r)[8], bf16x8 pa0, bf16x8 pa1, bf16x8 pa2, bf16x8 pa3) {
#define PK(L, H) (bf16x8){L[0], L[1], L[2], L[3], H[0], H[1], H[2], H[3]}
  od = __builtin_amdgcn_mfma_f32_32x32x16_bf16(pa0, PK(r[0], r[1]), od, 0, 0, 0);
  od = __builtin_amdgcn_mfma_f32_32x32x16_bf16(pa1, PK(r[2], r[3]), od, 0, 0, 0);
  od = __builtin_amdgcn_mfma_f32_32x32x16_bf16(pa2, PK(r[4], r[5]), od, 0, 0, 0);
  od = __builtin_amdgcn_mfma_f32_32x32x16_bf16(pa3, PK(r[6], r[7]), od, 0, 0, 0);
#undef PK
}
__device__ __forceinline__ void pv_d0(f32x16* o, int vb, bf16x8 pa0, bf16x8 pa1, bf16x8 pa2, bf16x8 pa3) {
  s16x4 ra[8], rb[8];
  pv_reads<0>(ra, vb); pv_reads<1>(rb, vb);
  asm volatile("s_waitcnt lgkmcnt(8)" ::: "memory"); SBAR(); pv_mma(o[0], ra, pa0, pa1, pa2, pa3); SBAR();
  pv_reads<2>(ra, vb);
  asm volatile("s_waitcnt lgkmcnt(8)" ::: "memory"); SBAR(); pv_mma(o[1], rb, pa0, pa1, pa2, pa3); SBAR();
  pv_reads<3>(rb, vb);
  asm volatile("s_waitcnt lgkmcnt(8)" ::: "memory"); SBAR(); pv_mma(o[2], ra, pa0, pa1, pa2, pa3); SBAR();
  asm volatile("s_waitcnt lgkmcnt(0)" ::: "memory"); SBAR(); pv_mma(o[3], rb, pa0, pa1, pa2, pa3);
}
__device__ __forceinline__ void attn_unit(const bf16_t* __restrict__ Qb, const bf16_t* __restrict__ KVh, const bf16_t* __restrict__ KPEh, bf16_t* __restrict__ Ob, int seq, char* lds, int ldsoff) {
  const int tid = tidx(), wid = tid >> 6, lane = tid & 63, r32 = lane & 31, hi = lane >> 5;
  char* V_lds = lds; char* K_lds = lds + 2 * SHM_V;
  float* ws = (float*)(lds + 2 * SHM_V + 2 * SHM_K) + wid * 64; float* li_l = ws; float* al_l = ws + 32;
  float m_reg = -1e30f, l_reg = 0; f32x16 o[4] = {}; bf16x8 qr[12];
  const bf16_t* Qw = Qb + (long)(wid * 32 + r32) * 1536 + hi * 8;
#pragma unroll
  for (int d0 = 0; d0 < 12; ++d0) qr[d0] = *reinterpret_cast<const bf16x8*>(Qw + d0 * 16);
  const int sr = tid >> 4, sc = (tid & 15) * 8, vst0 = v_st(sr, sc), vst1 = v_st(32 + sr, sc);
  const int pr = tid >> 3, pc = (tid & 7) * 8;
  const int vb0 = ldsoff + v_rd_base(lane);
  bf16x8 vs0, vs1, ks0, ks1, kp;
#define SLOAD(k0) do { vs0 = *reinterpret_cast<const bf16x8*>(&KVh[(long)((k0) + sr) * 2048 + 128 + sc]); vs1 = *reinterpret_cast<const bf16x8*>(&KVh[(long)((k0) + 32 + sr) * 2048 + 128 + sc]); \
    ks0 = *reinterpret_cast<const bf16x8*>(&KVh[(long)((k0) + sr) * 2048 + sc]); ks1 = *reinterpret_cast<const bf16x8*>(&KVh[(long)((k0) + 32 + sr) * 2048 + sc]); \
    kp = *reinterpret_cast<const bf16x8*>(&KPEh[(long)((k0) + pr) * 512 + pc]); } while (0)
#define SWRITE(b) do { *(bf16x8*)(V_lds + (b) * SHM_V + vst0) = vs0; *(bf16x8*)(V_lds + (b) * SHM_V + vst1) = vs1; \
    *(bf16x8*)(K_lds + (b) * SHM_K + KSWZ(sr, sc * 2)) = ks0; *(bf16x8*)(K_lds + (b) * SHM_K + KSWZ(32 + sr, sc * 2)) = ks1; \
    *(bf16x8*)(K_lds + (b) * SHM_K + KSWZ(pr, (128 + pc) * 2)) = kp; } while (0)
  f32x16 p0, p1; float mn, al; bf16x8 pa0, pa1, pa2, pa3; const int NT = seq / KVBLK;
  SLOAD(0); asm volatile("s_waitcnt vmcnt(0)" ::: "memory"); SWRITE(0); __syncthreads();
  for (int j = 0; j < NT; ++j) {
    const int b = j & 1;
    if (j + 1 < NT) SLOAD((j + 1) * KVBLK);
    SBAR();
    qkt(p0, p1, K_lds + b * SHM_K, qr, r32, hi);
    partialSM(p0, p1, m_reg, mn, al);
    if (__any(al < 1.f)) { if (hi == 0) al_l[r32] = al; asm volatile("s_waitcnt lgkmcnt(0)" ::: "memory");
#pragma unroll
      for (int d = 0; d < 4; ++d)
#pragma unroll
        for (int r = 0; r < 16; ++r) o[d][r] *= al_l[crow(r, hi)]; }
    finishSM(p0, p1, al, l_reg, pa0, pa1, pa2, pa3); SBAR();
    pv_d0(o, vb0 + b * SHM_V, pa0, pa1, pa2, pa3);
    if (j + 1 < NT) { asm volatile("s_waitcnt vmcnt(0)" ::: "memory"); SWRITE(b ^ 1); }
    __syncthreads();
  }
  if (hi == 0) li_l[r32] = l_reg; asm volatile("s_waitcnt lgkmcnt(0)" ::: "memory");
  float rli[16];
#pragma unroll
  for (int r = 0; r < 16; ++r) rli[r] = __builtin_amdgcn_rcpf(li_l[crow(r, hi)]);
  bf16_t* Ow = Ob + (long)(wid * 32) * 1024;
#pragma unroll
  for (int r = 0; r < 16; ++r) { const int orow = crow(r, hi);
#pragma unroll
    for (int d0 = 0; d0 < 4; ++d0) Ow[(long)orow * 1024 + d0 * 32 + r32] = f2bf(o[d0][r] * rli[r]); }
  __syncthreads();
#undef SLOAD
#undef SWRITE
}
}

namespace ret {
constexpr int RS = 528, TS = 144;
constexpr int QS = 0, KS = 33792;
constexpr int KTS = 0, STS = 36864, PS = 53760, VRS = 62976, VZS = 68096, OTS = 73216, VST = 80;
__device__ __forceinline__ f32x4 mma16(bf16x8 a, bf16x8 b, f32x4 c) { return __builtin_amdgcn_mfma_f32_16x16x32_bf16(a, b, c, 0, 0, 0); }
typedef short v4i16_t __attribute__((ext_vector_type(4)));
__device__ __forceinline__ bf16x8 vtr_frag_s(const LAS unsigned char* p0, int l15, int stride) {
  const LAS unsigned char* p = p0 + (l15 >> 2) * stride + (l15 & 3) * 8;
  const v4i16_t lo = __builtin_amdgcn_ds_read_tr16_b64_v4i16((LAS v4i16_t*)p), hi = __builtin_amdgcn_ds_read_tr16_b64_v4i16((LAS v4i16_t*)(p + 4 * stride));
  return (bf16x8){lo[0], lo[1], lo[2], lo[3], hi[0], hi[1], hi[2], hi[3]};
}
__device__ __forceinline__ bf16x8 vtr_frag(const LAS unsigned char* p0, int l15) { return vtr_frag_s(p0, l15, VST); }
__device__ __forceinline__ void p_unit(LAS unsigned char* L, const bf16_t* __restrict__ RQ, const bf16_t* __restrict__ RK, bf16_t* __restrict__ RKT, bf16_t* __restrict__ Pg, int c, int hd, float lg2f, float lg2b) {
  const int tid = tidx(), wid = tid >> 6, lane = tid & 63, l15 = lane & 15, g4 = lane >> 4;
  const int it = wid >> 1, jt0 = 2 * (wid & 1);
  const long tok0 = (long)c * 64;
#pragma unroll
  for (int i = 0; i < 4; ++i) { const int q = tid + 512 * i; const int row = q >> 5, c16 = q & 31;
    const u32x4 b = *(const u32x4*)(RK + (tok0 + row) * 1024 + hd * 256 + c16 * 8);
    *(LAS u32x4*)(L + KS + row * RS + c16 * 16) = b; }
  bf16x8 qa[8];
  { const bf16_t* qb_ = RQ + ((size_t)(c * 4 + hd) * 4 + it) * 4096 + lane * 8;
#pragma unroll
    for (int ks = 0; ks < 8; ++ks) qa[ks] = *(const bf16x8*)(qb_ + ks * 512); }
  __syncthreads();
#pragma unroll
  for (int a = 0; a < 2; ++a)
#pragma unroll
    for (int ks = 0; ks < 2; ++ks) { const int dt = 2 * wid + a;
      const bf16x8 f = vtr_frag_s(L + KS + (ks * 32 + 8 * g4) * RS + dt * 32, l15, RS);
      *(bf16x8*)(RKT + ((size_t)(c * 4 + hd) * 16 + dt) * 1024 + ks * 512 + lane * 8) = f; }
  f32x4 sS0 = {0.f, 0.f, 0.f, 0.f}, sS1 = {0.f, 0.f, 0.f, 0.f};
#pragma unroll
  for (int ks = 0; ks < 8; ++ks) { const int ko = (ks * 32 + 8 * g4) * 2;
    const bf16x8 a = qa[ks];
    const bf16x8 b0 = *(const LAS bf16x8*)(L + KS + (16 * jt0 + l15) * RS + ko);
    const bf16x8 b1 = *(const LAS bf16x8*)(L + KS + (16 * (jt0 + 1) + l15) * RS + ko);
    sS0 = mma16(a, b0, sS0); sS1 = mma16(a, b1, sS1); }
  bf16_t* Pf = Pg + ((size_t)(c * 4 + hd) * 2) * 4096; bf16_t* Pb = Pf + 4096;
#pragma unroll
  for (int r = 0; r < 4; ++r) { const int i = 16 * it + 4 * g4 + r; const int j0 = 16 * jt0 + l15, j1 = j0 + 16;
    const float f0 = (i >= j0) ? __builtin_amdgcn_exp2f((float)(i - j0) * lg2f) : 0.f, f1 = (i >= j1) ? __builtin_amdgcn_exp2f((float)(i - j1) * lg2f) : 0.f;
    const float b0 = (j0 > i) ? __builtin_amdgcn_exp2f((float)(j0 - i) * lg2b) : 0.f, b1 = (j1 > i) ? __builtin_amdgcn_exp2f((float)(j1 - i) * lg2b) : 0.f;
    Pf[i * 64 + j0] = f2bf(sS0[r] * f0); Pf[i * 64 + j1] = f2bf(sS1[r] * f1);
    Pb[i * 64 + j0] = f2bf(sS0[r] * b0); Pb[i * 64 + j1] = f2bf(sS1[r] * b1); }
  __syncthreads();
}
__device__ __forceinline__ void scan_item(LAS unsigned char* L, const bf16_t* __restrict__ RQ, const bf16_t* __restrict__ RKT, const bf16_t* __restrict__ RV, const bf16_t* __restrict__ Pg,
                                          bf16_t* __restrict__ Oo, int seqlen, int s, int hd, int dir, int sl, float lg2) {
  const int tid = tidx(), wid = __builtin_amdgcn_readfirstlane(tid >> 6), lane = tid & 63, l15 = lane & 15, g4 = lane >> 4;
  const int nchunk = seqlen >> 6;
  const long tokb = (long)s * seqlen;
#define CHUNK_OF(cc_) (dir ? nchunk - 1 - (cc_) : (cc_))
#define LOAD_P(PP, c) PP = *(const u32x4*)(Pg + ((size_t)(((tokb >> 6) + (c)) * 4 + hd) * 2 + dir) * 4096 + tid * 8)
#define STAGE_P(PP) *(LAS u32x4*)(L + PS + (tid >> 3) * TS + (tid & 7) * 16) = PP
  if (wid < 4) {
    const int it = wid;
    float xi[4];
#pragma unroll
    for (int r = 0; r < 4; ++r) { const int i = 16 * it + 4 * g4 + r; xi[r] = __builtin_amdgcn_exp2f((dir ? (float)(64 - i) : (float)(i + 1)) * lg2); }
    bf16x8 qfA[8], qfB[8]; u32x4 ppA, ppB;
#define LOAD_Q(QF, c) do { const bf16_t* qb_ = RQ + ((((tokb >> 6) + (c)) * 4 + hd) * 4 + it) * 4096 + lane * 8; \
      _Pragma("unroll") for (int ks = 0; ks < 8; ++ks) QF[ks] = *(const bf16x8*)(qb_ + ks * 512); } while (0)
#define X_STEP(QF, PP, CC) do { \
      const int c = CHUNK_OF(CC); \
      STAGE_P(PP); \
      __syncthreads(); \
      if ((CC) + 2 < nchunk) LOAD_P(PP, CHUNK_OF((CC) + 2)); \
      f32x4 c0 = {0.f, 0.f, 0.f, 0.f}, c1 = {0.f, 0.f, 0.f, 0.f}; \
      _Pragma("unroll") for (int ks = 0; ks < 8; ++ks) { const int ko = (ks * 32 + 8 * g4) * 2; \
        const bf16x8 s0 = *(const LAS bf16x8*)(L + STS + l15 * RS + ko), s1 = *(const LAS bf16x8*)(L + STS + (16 + l15) * RS + ko); \
        c0 = mma16(QF[ks], s0, c0); c1 = mma16(QF[ks], s1, c1); } \
      if ((CC) + 2 < nchunk) LOAD_Q(QF, CHUNK_OF((CC) + 2)); \
      _Pragma("unroll") for (int r = 0; r < 4; ++r) { c0[r] *= xi[r]; c1[r] *= xi[r]; } \
      _Pragma("unroll") for (int ks = 0; ks < 2; ++ks) { const int ko = (ks * 32 + 8 * g4) * 2; \
        const bf16x8 a = *(const LAS bf16x8*)(L + PS + (16 * it + l15) * TS + ko); \
        const bf16x8 v0 = vtr_frag(L + VRS + (ks * 32 + 8 * g4) * VST, l15), v1 = vtr_frag(L + VRS + (ks * 32 + 8 * g4) * VST + 32, l15); \
        c0 = mma16(a, v0, c0); c1 = mma16(a, v1, c1); } \
      _Pragma("unroll") for (int r = 0; r < 4; ++r) { \
        *(LAS unsigned short*)(L + OTS + (16 * it + 4 * g4 + r) * 80 + l15 * 2) = f2bf(c0[r]); \
        *(LAS unsigned short*)(L + OTS + (16 * it + 4 * g4 + r) * 80 + (16 + l15) * 2) = f2bf(c1[r]); } \
      __syncthreads(); \
      { const u32x4 w = *(const LAS u32x4*)(L + OTS + (tid >> 2) * 80 + (tid & 3) * 16); \
        *(u32x4*)(Oo + ((long)(hd * 16 + sl) * T_GRP + tokb + (long)c * 64 + (tid >> 2)) * 32 + (tid & 3) * 8) = w; } } while (0)
    LOAD_P(ppA, CHUNK_OF(0)); LOAD_Q(qfA, CHUNK_OF(0));
    LOAD_P(ppB, CHUNK_OF(1)); LOAD_Q(qfB, CHUNK_OF(1));
#pragma unroll 1
    for (int cc = 0; cc < nchunk; cc += 2) { X_STEP(qfA, ppA, cc); X_STEP(qfB, ppB, cc + 1); }
#undef X_STEP
#undef LOAD_Q
  } else {
    const int w4 = wid - 4, t2 = tid - 256;
    const int vrow = t2 >> 2, vc4 = t2 & 3;
    const float zeta = __builtin_amdgcn_exp2f((dir ? (float)vrow : (float)(63 - vrow)) * lg2);
    const float gch = __builtin_amdgcn_exp2f(64.f * lg2);
    f32x4 st[4][2];
#pragma unroll
    for (int a = 0; a < 4; ++a)
#pragma unroll
      for (int b = 0; b < 2; ++b) st[a][b] = (f32x4){0.f, 0.f, 0.f, 0.f};
    bf16x8 ktA[4][2], ktB[4][2]; u32x4 pvA, pvB, ppA, ppB;
#define LOAD_K(KT, c) do { const bf16_t* kb_ = RKT + (((((tokb >> 6) + (c)) * 4 + hd) * 16) + 4 * w4) * 1024 + lane * 8; \
      _Pragma("unroll") for (int a = 0; a < 4; ++a) _Pragma("unroll") for (int ks = 0; ks < 2; ++ks) KT[a][ks] = *(const bf16x8*)(kb_ + a * 1024 + ks * 512); } while (0)
#define LOAD_V(PV, c) PV = *(const u32x4*)(RV + (tokb + (long)(c) * 64 + vrow) * 2048 + hd * 512 + sl * 32 + vc4 * 8)
#define S_STEP(KT, PV, PP, CC) do { \
      STAGE_P(PP); \
      { u32x4 wz; wz.x = cvt_pk_bf16(bflo(PV.x) * zeta, bfhi(PV.x) * zeta); wz.y = cvt_pk_bf16(bflo(PV.y) * zeta, bfhi(PV.y) * zeta); \
        wz.z = cvt_pk_bf16(bflo(PV.z) * zeta, bfhi(PV.z) * zeta); wz.w = cvt_pk_bf16(bflo(PV.w) * zeta, bfhi(PV.w) * zeta); \
        *(LAS u32x4*)(L + VRS + vrow * VST + vc4 * 16) = PV; *(LAS u32x4*)(L + VZS + vrow * VST + vc4 * 16) = wz; } \
      _Pragma("unroll") for (int a = 0; a < 4; ++a) _Pragma("unroll") for (int b = 0; b < 2; ++b) { const int d = 16 * (4 * w4 + a) + 4 * g4, dv = 16 * b + l15; \
          u32x2 w; w.x = cvt_pk_bf16(st[a][b][0], st[a][b][1]); w.y = cvt_pk_bf16(st[a][b][2], st[a][b][3]); \
          *(LAS u32x2*)(L + STS + dv * RS + d * 2) = w; } \
      __syncthreads(); \
      if ((CC) + 2 < nchunk) { LOAD_P(PP, CHUNK_OF((CC) + 2)); LOAD_V(PV, CHUNK_OF((CC) + 2)); } \
      _Pragma("unroll") for (int a = 0; a < 4; ++a) _Pragma("unroll") for (int b = 0; b < 2; ++b) st[a][b] *= gch; \
      _Pragma("unroll") for (int ks = 0; ks < 2; ++ks) { \
        const bf16x8 b0 = vtr_frag(L + VZS + (ks * 32 + 8 * g4) * VST, l15), b1 = vtr_frag(L + VZS + (ks * 32 + 8 * g4) * VST + 32, l15); \
        _Pragma("unroll") for (int a = 0; a < 4; ++a) { st[a][0] = mma16(KT[a][ks], b0, st[a][0]); st[a][1] = mma16(KT[a][ks], b1, st[a][1]); } } \
      if ((CC) + 2 < nchunk) LOAD_K(KT, CHUNK_OF((CC) + 2)); \
      __syncthreads(); } while (0)
    LOAD_P(ppA, CHUNK_OF(0)); LOAD_V(pvA, CHUNK_OF(0)); LOAD_K(ktA, CHUNK_OF(0));
    LOAD_P(ppB, CHUNK_OF(1)); LOAD_V(pvB, CHUNK_OF(1)); LOAD_K(ktB, CHUNK_OF(1));
#pragma unroll 1
    for (int cc = 0; cc < nchunk; cc += 2) { S_STEP(ktA, pvA, ppA, cc); S_STEP(ktB, pvB, ppB, cc + 1); }
#undef S_STEP
#undef LOAD_K
#undef LOAD_V
  }
#undef STAGE_P
#undef LOAD_P
#undef CHUNK_OF
}
}

__device__ __forceinline__ size_t bt_off(int n, int k, int K) {
  const int Rb = n & 127, c = Rb & 31, rho = 16 * ((c >> 2) & 1) + 4 * (c >> 3) + (c & 3), R = (Rb & ~31) + rho;
  return ((size_t)((n >> 7) * (K >> 6) + (k >> 6)) << 13) + (size_t)(pg8::lds_byte(R, k & 63) >> 1);
}
__device__ __forceinline__ void prep_T(float* tile, const float* __restrict__ W, int K, int N, bf16_t* __restrict__ Bt, int mode, int row_off, int& base) {
  const int G = gridDim.x, tid = tidx();
  const int tn = N >> 6, ntile = (K >> 6) * tn;
  int t0 = ((int)blockIdx.x - base % G + G) % G;
  for (int t = t0; t < ntile; t += G) {
    const int k0 = (t / tn) << 6, n0 = (t % tn) << 6;
#pragma unroll
    for (int i = 0; i < 2; ++i) { const int kr = (tid >> 4) + 32 * i, nc = (tid & 15) * 4;
      const f32x4 v = *(const f32x4*)(W + (size_t)(k0 + kr) * N + n0 + nc);
      tile[kr * 65 + nc] = v[0]; tile[kr * 65 + nc + 1] = v[1]; tile[kr * 65 + nc + 2] = v[2]; tile[kr * 65 + nc + 3] = v[3]; }
    __syncthreads();
    { const int n = tid >> 3, kc = (tid & 7) * 8; const int nn = n0 + n;
      const int orow = (mode == 0 ? nn : ((nn >> 7) * 256 + (nn & 127))) + row_off;
      u32x4 w;
      w.x = cvt_pk_bf16(tile[(kc + 0) * 65 + n], tile[(kc + 1) * 65 + n]); w.y = cvt_pk_bf16(tile[(kc + 2) * 65 + n], tile[(kc + 3) * 65 + n]);
      w.z = cvt_pk_bf16(tile[(kc + 4) * 65 + n], tile[(kc + 5) * 65 + n]); w.w = cvt_pk_bf16(tile[(kc + 6) * 65 + n], tile[(kc + 7) * 65 + n]);
      *(u32x4*)(Bt + bt_off(orow, k0 + kc, K)) = w; }
    __syncthreads();
  }
  base += ntile;
}
__device__ __forceinline__ void prep_layer(float* tile, const Params& P, int layer) {
  bf16_t* Wb = (bf16_t*)(P.ws + WS_W); int base = 0; const int j = layer >> 1;
#pragma unroll 1
  for (int s = 0; s < 2; ++s) {
    const size_t off = (size_t)(layer * 2 + s) * DM * FF;
    bf16_t* gu = Wb + (s ? WE_GU1 : WE_GU0); bf16_t* dn = Wb + (s ? WE_D1 : WE_D0);
    prep_T(tile, P.ffn_g + off, DM, FF, gu, 1, 0, base);
    prep_T(tile, P.ffn_u + off, DM, FF, gu, 1, 128, base);
    prep_T(tile, P.ffn_d + off, FF, DM, dn, 0, 0, base);
  }
  if ((layer & 1) == 0) {
    prep_T(tile, P.m_dq + (size_t)j * 1024 * 384, 1024, 384, Wb + WE_DQKV, 0, 0, base);
    prep_T(tile, P.m_dkv + (size_t)j * 1024 * 320, 1024, 320, Wb + WE_DQKV, 0, 384, base);
    prep_T(tile, P.m_uq + (size_t)j * 384 * 1536, 384, 1536, Wb + WE_UQ, 0, 0, base);
    prep_T(tile, P.m_ukv + (size_t)j * 256 * 2048, 256, 2048, Wb + WE_UKV, 0, 0, base);
    prep_T(tile, P.m_wo + (size_t)j * 1024 * 1024, 1024, 1024, Wb + WE_MO, 0, 0, base);
    for (int i = blockIdx.x * 512 + tidx(); i < 64 * 1024 / 8; i += gridDim.x * 512) *(u32x4*)(Wb + WE_DQKV + bt_off(704 + (i >> 7), (i & 127) * 8, 1024)) = (u32x4){0u, 0u, 0u, 0u};
  } else {
    prep_T(tile, P.r_in + (size_t)j * 1024 * 6144, 1024, 6144, Wb + WE_RIN, 0, 0, base);
    prep_T(tile, P.r_wo + (size_t)j * 2048 * 1024, 2048, 1024, Wb + WE_RO, 0, 0, base);
  }
}
__device__ __forceinline__ void build_tables(const Params& P) {
  float* c64 = (float*)(P.ws + WS_TAB); float* s64 = c64 + 8192 * 32; float* c256 = s64 + 8192 * 32; float* s256 = c256 + 8192 * 128;
  const int lane = tidx() & 63, gw = blockIdx.x * 8 + (tidx() >> 6), nw = gridDim.x * 8;
  for (int pos = gw; pos < 8192; pos += nw)
  for (int k = lane; k < 160; k += 64) {
    double rb = (k < 32) ? 0.7498942093324559 : 0.930572040929699; int e = (k < 32) ? k : k - 32; double inv = 1.0;
#pragma unroll 1
    for (; e > 0; e >>= 1) { if (e & 1) inv *= rb; rb *= rb; }
    const double rev = (double)pos * inv * 0.15915494309189535;
    const float f = (float)(rev - rint(rev));
    const float c = __builtin_amdgcn_cosf(f), s = __builtin_amdgcn_sinf(f);
    if (k < 32) { c64[pos * 32 + k] = c; s64[pos * 32 + k] = s; } else { c256[pos * 128 + k - 32] = c; s256[pos * 128 + k - 32] = s; }
  }
}
__device__ __forceinline__ void rows_norm(int mode, const Params& P, const float* __restrict__ g1, const float* __restrict__ g2) {
  bf16_t* H = (bf16_t*)P.out; bf16_t* XN = (bf16_t*)(P.ws + WS_XN); float* OUTF = (float*)(P.ws + WS_S);
  const int lane = tidx() & 63, gw = blockIdx.x * 8 + (tidx() >> 6), nw = gridDim.x * 8;
  for (int row0 = gw; row0 < T_ALL; row0 += 2 * nw) {
    f32x4 vv[2][4];
#pragma unroll
    for (int h = 0; h < 2; ++h) { const int row = row0 + h * nw; if (row < T_ALL) {
        if (mode == 0) { const float* src = row < T_GRP ? P.xp + (size_t)row * DM : P.xs + (size_t)(row - T_GRP) * DM;
#pragma unroll
          for (int i = 0; i < 4; ++i) vv[h][i] = *(const f32x4*)(src + i * 256 + lane * 4);
        } else {
#pragma unroll
          for (int i = 0; i < 4; ++i) { const u32x2 w = *(const u32x2*)(H + (size_t)row * DM + i * 256 + lane * 4); vv[h][i] = (f32x4){bflo(w.x), bfhi(w.x), bflo(w.y), bfhi(w.y)}; } } } }
#pragma unroll
    for (int h = 0; h < 2; ++h) { const int row = row0 + h * nw; if (row >= T_ALL) continue;
      f32x4 v[4]; float ss = 0.f;
#pragma unroll
      for (int i = 0; i < 4; ++i) { v[i] = vv[h][i]; ss += v[i][0] * v[i][0] + v[i][1] * v[i][1] + v[i][2] * v[i][2] + v[i][3] * v[i][3]; }
      ss = wave_sum(ss); const float rstd = rsqrtf(ss * (1.f / DM) + EPS);
      if (mode == 0) {
#pragma unroll
        for (int i = 0; i < 4; ++i) { u32x2 w; w.x = cvt_pk_bf16(v[i][0], v[i][1]); w.y = cvt_pk_bf16(v[i][2], v[i][3]); *(u32x2*)(H + (size_t)row * DM + i * 256 + lane * 4) = w; } }
      float ss2 = 0.f;
#pragma unroll
      for (int i = 0; i < 4; ++i) { const f32x4 gg = *(const f32x4*)(g1 + i * 256 + lane * 4); v[i] = v[i] * rstd * gg; ss2 += v[i][0] * v[i][0] + v[i][1] * v[i][1] + v[i][2] * v[i][2] + v[i][3] * v[i][3]; }
      if (mode == 3) {
        float* dst = (row >= T_ALL / 2) ? P.out : OUTF;
#pragma unroll
        for (int i = 0; i < 4; ++i) *(f32x4*)(dst + (size_t)row * DM + i * 256 + lane * 4) = v[i];
        continue; }
      if (mode == 2) {
#pragma unroll
        for (int i = 0; i < 4; ++i) { u32x2 w; w.x = cvt_pk_bf16(v[i][0], v[i][1]); w.y = cvt_pk_bf16(v[i][2], v[i][3]); *(u32x2*)(H + (size_t)row * DM + i * 256 + lane * 4) = w; }
        ss2 = wave_sum(ss2); const float rstd2 = rsqrtf(ss2 * (1.f / DM) + EPS);
#pragma unroll
        for (int i = 0; i < 4; ++i) { const f32x4 gg = *(const f32x4*)(g2 + i * 256 + lane * 4); v[i] = v[i] * rstd2 * gg; }
      }
#pragma unroll
      for (int i = 0; i < 4; ++i) { u32x2 w; w.x = cvt_pk_bf16(v[i][0], v[i][1]); w.y = cvt_pk_bf16(v[i][2], v[i][3]); *(u32x2*)(XN + (size_t)row * DM + i * 256 + lane * 4) = w; }
    }
  }
}
__device__ __forceinline__ void copy_out(const Params& P) {
  const u32x4* s = (const u32x4*)(P.ws + WS_S); u32x4* d = (u32x4*)P.out;
  const size_t n = (size_t)(T_ALL / 2) * DM / 4, nth = (size_t)gridDim.x * 512;
  for (size_t i = (size_t)blockIdx.x * 512 + tidx(); i < n; i += nth) d[i] = s[i];
}
__device__ __forceinline__ void rows_mla_a(const Params& P, int j) {
  bf16_t* C = (bf16_t*)(P.ws + WS_S + S_CQKV); const float* qa = P.m_qa + j * 384; const float* kva = P.m_kva + j * 256;
  const int lane = tidx() & 63, gw = blockIdx.x * 8 + (tidx() >> 6), nw = gridDim.x * 8;
  for (int row = gw; row < T_ALL; row += nw) {
    bf16_t* r = C + (size_t)row * 768;
    unsigned q[3]; float ssq = 0.f;
#pragma unroll
    for (int i = 0; i < 3; ++i) { q[i] = *(const unsigned*)(r + i * 128 + lane * 2); const float a = bflo(q[i]), b = bfhi(q[i]); ssq += a * a + b * b; }
    const u32x2 kk = *(const u32x2*)(r + 384 + lane * 4);
    float kv[4] = {bflo(kk.x), bfhi(kk.x), bflo(kk.y), bfhi(kk.y)};
    float ssk = kv[0] * kv[0] + kv[1] * kv[1] + kv[2] * kv[2] + kv[3] * kv[3];
    ssq = wave_sum(ssq); ssk = wave_sum(ssk);
    const float rq = rsqrtf(ssq * (1.f / 384.f) + EPS), rk = rsqrtf(ssk * (1.f / 256.f) + EPS);
#pragma unroll
    for (int i = 0; i < 3; ++i) { const int c = i * 128 + lane * 2; *(unsigned*)(r + c) = cvt_pk_bf16(bflo(q[i]) * rq * qa[c], bfhi(q[i]) * rq * qa[c + 1]); }
    { const int c = lane * 4; u32x2 w; w.x = cvt_pk_bf16(kv[0] * rk * kva[c], kv[1] * rk * kva[c + 1]); w.y = cvt_pk_bf16(kv[2] * rk * kva[c + 2], kv[3] * rk * kva[c + 3]); *(u32x2*)(r + 384 + c) = w; }
  }
}
__device__ __forceinline__ void rows_mla_b(const Params& P, int j, int grp) {
  bf16_t* Qg = (bf16_t*)(P.ws + WS_S + S_Q); bf16_t* KVg = (bf16_t*)(P.ws + WS_S + S_KV); bf16_t* KPE = (bf16_t*)(P.ws + WS_S + S_KPE);
  const bf16_t* C = (const bf16_t*)(P.ws + WS_S + S_CQKV);
  const float* qn = P.m_qn + j * 192; const float* kn = P.m_kn + j * 192;
  const float* c64 = (const float*)(P.ws + WS_TAB); const float* s64 = c64 + 8192 * 32;
  const int lane = tidx() & 63, gw = blockIdx.x * 8 + (tidx() >> 6), nw = gridDim.x * 8;
  const int hd = lane >> 3, sub = lane & 7; const int seqmask = grp == 0 ? 4095 : 8191;
  for (int t = gw; t < T_GRP; t += nw) {
    const int pos = t & seqmask; const size_t grow = (size_t)grp * T_GRP + t;
    const float* cp = c64 + pos * 32 + (sub & 3) * 8; const float* sp = s64 + pos * 32 + (sub & 3) * 8;
    float cs[8], sn[8];
#pragma unroll
    for (int e = 0; e < 8; ++e) { cs[e] = cp[e]; sn[e] = sp[e]; }
    { bf16_t* qp = Qg + (size_t)t * 1536 + hd * 192 + sub * 8;
      float x[24]; float ss = 0.f;
#pragma unroll
      for (int c = 0; c < 3; ++c) { const u32x4 w = *(const u32x4*)(qp + 64 * c); const unsigned ww[4] = {w.x, w.y, w.z, w.w};
#pragma unroll
        for (int e = 0; e < 4; ++e) { x[c * 8 + 2 * e] = bflo(ww[e]); x[c * 8 + 2 * e + 1] = bfhi(ww[e]); } }
#pragma unroll
      for (int e = 0; e < 24; ++e) ss += x[e] * x[e];
      ss += __shfl_xor(ss, 1); ss += __shfl_xor(ss, 2); ss += __shfl_xor(ss, 4);
      const float rstd = rsqrtf(ss * (1.f / 192.f) + EPS);
#pragma unroll
      for (int c = 0; c < 3; ++c)
#pragma unroll
        for (int e = 0; e < 8; ++e) x[c * 8 + e] *= rstd * qn[c * 64 + sub * 8 + e];
#pragma unroll
      for (int e = 0; e < 8; ++e) { const float own = x[16 + e]; const float oth = __shfl_xor(own, 4);
        x[16 + e] = (sub < 4) ? (own * cs[e] - oth * sn[e]) : (own * cs[e] + oth * sn[e]); }
#pragma unroll
      for (int c = 0; c < 3; ++c) { u32x4 w; w.x = cvt_pk_bf16(x[c * 8], x[c * 8 + 1]); w.y = cvt_pk_bf16(x[c * 8 + 2], x[c * 8 + 3]); w.z = cvt_pk_bf16(x[c * 8 + 4], x[c * 8 + 5]); w.w = cvt_pk_bf16(x[c * 8 + 6], x[c * 8 + 7]);
        *(u32x4*)(qp + 64 * c) = w; }
    }
    { bf16_t* kp = KVg + (size_t)t * 2048 + hd * 256 + sub * 8; const bf16_t* pp = C + grow * 768 + 640 + sub * 8;
      float x[24]; float ss = 0.f;
#pragma unroll
      for (int c = 0; c < 3; ++c) { const u32x4 w = (c < 2) ? *(const u32x4*)(kp + 64 * c) : *(const u32x4*)pp; const unsigned ww[4] = {w.x, w.y, w.z, w.w};
#pragma unroll
        for (int e = 0; e < 4; ++e) { x[c * 8 + 2 * e] = bflo(ww[e]); x[c * 8 + 2 * e + 1] = bfhi(ww[e]); } }
#pragma unroll
      for (int e = 0; e < 24; ++e) ss += x[e] * x[e];
      ss += __shfl_xor(ss, 1); ss += __shfl_xor(ss, 2); ss += __shfl_xor(ss, 4);
      const float rstd = rsqrtf(ss * (1.f / 192.f) + EPS);
#pragma unroll
      for (int c = 0; c < 3; ++c)
#pragma unroll
        for (int e = 0; e < 8; ++e) x[c * 8 + e] *= rstd * kn[c * 64 + sub * 8 + e];
#pragma unroll
      for (int e = 0; e < 8; ++e) { const float own = x[16 + e]; const float oth = __shfl_xor(own, 4);
        x[16 + e] = (sub < 4) ? (own * cs[e] - oth * sn[e]) : (own * cs[e] + oth * sn[e]); }
#pragma unroll
      for (int c = 0; c < 2; ++c) { u32x4 w; w.x = cvt_pk_bf16(x[c * 8], x[c * 8 + 1]); w.y = cvt_pk_bf16(x[c * 8 + 2], x[c * 8 + 3]); w.z = cvt_pk_bf16(x[c * 8 + 4], x[c * 8 + 5]); w.w = cvt_pk_bf16(x[c * 8 + 6], x[c * 8 + 7]);
        *(u32x4*)(kp + 64 * c) = w; }
      { u32x4 w; w.x = cvt_pk_bf16(x[16], x[17]); w.y = cvt_pk_bf16(x[18], x[19]); w.z = cvt_pk_bf16(x[20], x[21]); w.w = cvt_pk_bf16(x[22], x[23]);
        *(u32x4*)(KPE + (size_t)t * 512 + hd * 64 + sub * 8) = w; }
    }
  }
}
__device__ __forceinline__ void rows_ret_gn(const Params& P, int j) {
  bf16_t* Y = (bf16_t*)(P.ws + WS_S + S_RQ); const bf16_t* OF = (const bf16_t*)(P.ws + WS_S + S_OF); const bf16_t* OB = (const bf16_t*)(P.ws + WS_S + S_OB); const bf16_t* RG = (const bf16_t*)(P.ws + WS_S + S_RG);
  const float* gn = P.r_gn + j * 2048;
  const int lane = tidx() & 63, gw = blockIdx.x * 8 + (tidx() >> 6), nw = gridDim.x * 8;
  for (int task0 = gw; task0 < T_GRP * 4; task0 += 4 * nw) {
    u32x4 av[4], bv[4], gv[4];
#pragma unroll
    for (int h = 0; h < 4; ++h) { const int task = task0 + h * nw; if (task < T_GRP * 4) {
        const size_t off = (size_t)(task >> 2) * 2048 + (task & 3) * 512 + lane * 8;
        const size_t offo = ((size_t)((task & 3) * 16 + (lane >> 2)) * T_GRP + (task >> 2)) * 32 + (lane & 3) * 8;
        av[h] = *(const u32x4*)(OF + offo); bv[h] = *(const u32x4*)(OB + offo); gv[h] = *(const u32x4*)(RG + off); } }
#pragma unroll
    for (int h = 0; h < 4; ++h) { const int task = task0 + h * nw; if (task >= T_GRP * 4) continue;
      const size_t off = (size_t)(task >> 2) * 2048 + (task & 3) * 512 + lane * 8;
      const u32x4 a = av[h], b = bv[h], g = gv[h];
      const unsigned aw[4] = {a.x, a.y, a.z, a.w}, bw[4] = {b.x, b.y, b.z, b.w}, gw4[4] = {g.x, g.y, g.z, g.w};
      float o[8]; float sm = 0.f;
#pragma unroll
      for (int e = 0; e < 4; ++e) { o[2 * e] = bflo(aw[e]) + bflo(bw[e]); o[2 * e + 1] = bfhi(aw[e]) + bfhi(bw[e]); sm += o[2 * e] + o[2 * e + 1]; }
      sm = wave_sum(sm); const float mu = sm * (1.f / 512.f);
      float vs = 0.f;
#pragma unroll
      for (int e = 0; e < 8; ++e) { o[e] -= mu; vs += o[e] * o[e]; }
      vs = wave_sum(vs); const float rstd = rsqrtf(vs * (1.f / 512.f) + EPS);
      const float* gp = gn + (task & 3) * 512 + lane * 8;
      float y[8];
#pragma unroll
      for (int e = 0; e < 4; ++e) { y[2 * e] = o[2 * e] * rstd * gp[2 * e] * bflo(gw4[e]); y[2 * e + 1] = o[2 * e + 1] * rstd * gp[2 * e + 1] * bfhi(gw4[e]); }
      u32x4 w; w.x = cvt_pk_bf16(y[0], y[1]); w.y = cvt_pk_bf16(y[2], y[3]); w.z = cvt_pk_bf16(y[4], y[5]); w.w = cvt_pk_bf16(y[6], y[7]);
      *(u32x4*)(Y + off) = w;
    }
  }
}


#define XB_TMO      128
#define XB_XCNT(j)  (256  + 64 * (j))
#define XB_XSUB(j)  (1280 + 64 * (j))
#define XB_XGEN(j)  (2304 + 64 * (j))
#define XB_TOP      3328
#define XB_TOPGEN   3392
#define XCD_BAR_WORDS 3456
#define XB_SPIN_CAP (1u << 22)
__device__ __forceinline__ unsigned xb_ld(unsigned* p)              { return __hip_atomic_load(p, __ATOMIC_RELAXED, __HIP_MEMORY_SCOPE_AGENT); }
__device__ __forceinline__ unsigned xb_add(unsigned* p, unsigned v) { return __hip_atomic_fetch_add(p, v, __ATOMIC_RELAXED, __HIP_MEMORY_SCOPE_AGENT); }
__device__ __forceinline__ unsigned xb_xcc_id() { return (unsigned)__builtin_amdgcn_s_getreg((3 << 11) | 20) & 0xFu; }
#define XB_SPIN(cond, bar) do { unsigned _sp = 0; while (cond) { __builtin_amdgcn_s_sleep(1); \
    if ((++_sp & 255u) == 0u) { if (xb_ld(&(bar)[XB_TMO])) break; if (_sp > XB_SPIN_CAP) { atomicAdd(&(bar)[XB_TMO], 1u); break; } } } } while (0)
__device__ __forceinline__ void xcd_barrier_complete(unsigned* bar, unsigned x, unsigned& nloc, unsigned& nx) {
    const unsigned G = gridDim.x;
    unsigned sum, cnt, mine, sp = 0u;
    for (;;) {
        sum = 0u; cnt = 0u; mine = 0u;
#pragma unroll
        for (unsigned j = 0; j < 16; ++j) { const unsigned c = xb_ld(&bar[XB_XCNT(j)]); sum += c; cnt += (c > 0u) ? 1u : 0u; mine = (j == x) ? c : mine; }
        if (sum == G) break;
        __builtin_amdgcn_s_sleep(1);
        if ((++sp & 255u) == 0u) { if (xb_ld(&bar[XB_TMO])) break; if (sp > XB_SPIN_CAP) { atomicAdd(&bar[XB_TMO], 1u); break; } }
    }
    nloc = mine > 0u ? mine : 1u; nx = cnt > 0u ? cnt : 1u;
}
__device__ __forceinline__ void xcd_barrier(unsigned* bar, unsigned x, volatile LAS unsigned* st) {
    asm volatile("s_waitcnt vmcnt(0)" ::: "memory");
    __syncthreads();
    if (threadIdx.x == 0) {
        __builtin_amdgcn_s_waitcnt(0);
        unsigned nloc = st[0], nx = st[1];
        if (nloc == 0u) { xcd_barrier_complete(bar, x, nloc, nx); st[0] = nloc; st[1] = nx; }
        const unsigned old = xb_add(&bar[XB_XSUB(x)], 1u);
        const unsigned gen = old / nloc;
        if (old + 1u == (gen + 1u) * nloc) {
            __builtin_amdgcn_fence(__ATOMIC_RELEASE, "agent");
            asm volatile("s_waitcnt vmcnt(0)" ::: "memory");
            const unsigned og = xb_add(&bar[XB_TOP], 1u);
            const unsigned tg = og / nx;
            if (og + 1u == (tg + 1u) * nx) xb_add(&bar[XB_TOPGEN], 1u);
            else XB_SPIN(xb_ld(&bar[XB_TOPGEN]) == tg, bar);
            __builtin_amdgcn_fence(__ATOMIC_ACQUIRE, "agent");
            xb_add(&bar[XB_XGEN(x)], 1u);
            asm volatile("s_waitcnt vmcnt(0)" ::: "memory");
        } else {
            XB_SPIN(xb_ld(&bar[XB_XGEN(x)]) == gen, bar);
            __builtin_amdgcn_fence(__ATOMIC_ACQUIRE, "agent");
            asm volatile("s_waitcnt vmcnt(0)" ::: "memory");
        }
    }
    __syncthreads();
}
#define GRID_BARRIER(wsptr) xcd_barrier((unsigned*)((wsptr) + WS_BAR), xcc_id, (volatile LAS unsigned*)(L + LDS_BYTES - 64))
constexpr int PH_PER_LAYER = 19, N_PHASES = 2 + 4 * PH_PER_LAYER;
__global__ void __launch_bounds__(512, 2) mega(Params Pk) {
  extern __shared__ __attribute__((aligned(16))) unsigned char lds_raw[];
  cg::grid_group grid = cg::this_grid();
  LAS unsigned char* L = (LAS unsigned char*)lds_raw;
  const int G = gridDim.x;
  const int ph_lo = Pk.ph_lo, ph_hi = Pk.ph_hi;
  if (ph_lo < 0) grid.sync();
  const unsigned xcc_id = xb_xcc_id();
  if (threadIdx.x < 16) ((volatile LAS unsigned*)(L + LDS_BYTES - 64))[threadIdx.x] = 0u;
  if (threadIdx.x == 0) (void)xb_add(&((unsigned*)(Pk.ws + WS_BAR))[XB_XCNT(xcc_id)], 1u);
  __syncthreads();
#ifdef TPROBE
  unsigned long long tacc = 0;
#endif
#pragma unroll 1
  for (int ph = ph_lo; ph < ph_hi; ++ph) {
#if defined(__HIP_DEVICE_COMPILE__)
    const __attribute__((address_space(4))) Params* pp = (const __attribute__((address_space(4))) Params*)__builtin_amdgcn_kernarg_segment_ptr();
    asm volatile("" : "+s"(pp));
    const Params P = *pp;
#else
    const Params P = Pk;
#endif
    bf16_t* Wb = (bf16_t*)(P.ws + WS_W); bf16_t* XN = (bf16_t*)(P.ws + WS_XN); unsigned char* SB = P.ws + WS_S;
    bf16_t* H = (bf16_t*)P.out;
#ifdef TPROBE
    int cls_op = 100, cls_p = 0, cls_ret = 0; const unsigned long long tp0 = __builtin_amdgcn_s_memrealtime();
#endif
    if (ph == 0) {
      prep_layer((float*)lds_raw, P, 0); build_tables(P); rows_norm(0, P, P.norm_g, nullptr);
    } else if (ph == N_PHASES - 1) {
      copy_out(P);
    } else {
      const int layer = (ph - 1) / PH_PER_LAYER, p = (ph - 1) % PH_PER_LAYER, j = layer >> 1; const bool is_ret = layer & 1;
      const float* ng = P.norm_g + layer * 4 * DM;
      int op = 0, grp = 0, s = 0;
      if (p == 0 || p == 16) { op = 0; s = (p == 16); }
      else if (p == 1 || p == 17) { op = 1; s = (p == 17); }
      else if (p == 2 || p == 15) op = 2;
      else if (p == 18) op = 3;
      else if (!is_ret) {
        if (p == 3) op = 4; else if (p == 4) op = 5; else if (p == 14) op = 1;
        else { grp = (p - 5) / 3; const int sub = (p - 5) % 3; op = sub == 0 ? 4 : (sub == 1 ? 6 : 7); }
      } else { grp = (p - 3) / 4; const int sub = (p - 3) % 4; op = sub == 0 ? 8 : (sub == 1 ? 9 : (sub == 2 ? 10 : 1)); }
      const int seqlen = grp == 0 ? 4096 : 8192, nseq = grp == 0 ? 4 : 2;
#ifdef TPROBE
      cls_op = op; cls_p = p; cls_ret = is_ret;
#endif

      if (op == 0) {
        pg8::Gemm g{XN, Wb + (s ? WE_GU1 : WE_GU0), T_ALL, 2 * FF, DM, DM}; pg8::StaticOrder S; S.init(T_ALL, 2 * FF, G, blockIdx.x);
        pg8::EpiSwiGLU E{(bf16_t*)(SB + S_ACT)};
#ifndef REP_FFNUP
#define REP_FFNUP 1
#endif
#pragma unroll 1
        for (int rep = 0; rep < REP_FFNUP; ++rep) pg8::gemm_phase(L, g, S, E);
      } else if (op == 1) {
        pg8::Gemm g; bf16_t* Hh = H; float alpha = 0.5f;
        if (p == 1 || p == 17) g = pg8::Gemm{(const bf16_t*)(SB + S_ACT), Wb + (s ? WE_D1 : WE_D0), T_ALL, DM, FF, FF};
        else if (!is_ret) { g = pg8::Gemm{XN, Wb + WE_MO, T_ALL, DM, DM, DM}; alpha = 1.f; }
        else { g = pg8::Gemm{(const bf16_t*)(SB + S_RQ), Wb + WE_RO, T_GRP, DM, 2048, 2048}; alpha = 1.f; Hh = H + (size_t)grp * T_GRP * DM; }
        pg8::StaticOrder S; S.init(g.M, DM, G, blockIdx.x);
#ifndef REP_RESID
#define REP_RESID 1
#endif
#pragma unroll 1
        for (int rep = 0; rep < REP_RESID; ++rep) { pg8::EpiResid E{Hh, (rep == REP_RESID - 1) ? alpha : 0.f}; pg8::gemm_phase(L, g, S, E); }
      } else if (op == 2) {
#ifndef REP_NORM
#define REP_NORM 1
#endif
        for (int rn_ = 0; rn_ < REP_NORM; ++rn_) rows_norm(1, P, ng + (p == 2 ? 1 : 2) * DM, nullptr);
      } else if (op == 3) {
#ifndef REP_PREP
#define REP_PREP 1
#endif
        for (int rep = 0; rep < REP_PREP; ++rep) if (layer < 3) prep_layer((float*)lds_raw, P, layer + 1);
        rows_norm(layer < 3 ? 2 : 3, P, ng + 3 * DM, layer < 3 ? ng + 4 * DM : nullptr);
      } else if (op == 4) {
        const int ng2 = (p == 3) ? 1 : 2;
#pragma unroll 1
#ifndef REP_BF16
#define REP_BF16 1
#endif
        for (int gi = 0; gi < ng2 * REP_BF16; ++gi) {
          pg8::Gemm g; pg8::EpiBf16 E;
          if (p == 3) { g = pg8::Gemm{XN, Wb + WE_DQKV, T_ALL, 768, DM, DM}; E = pg8::EpiBf16{(bf16_t*)(SB + S_CQKV), 768}; }
          else if ((gi & 1) == 0) { g = pg8::Gemm{(const bf16_t*)(SB + S_CQKV) + (size_t)grp * T_GRP * 768, Wb + WE_UQ, T_GRP, 1536, 384, 768}; E = pg8::EpiBf16{(bf16_t*)(SB + S_Q), 1536}; }
          else { g = pg8::Gemm{(const bf16_t*)(SB + S_CQKV) + (size_t)grp * T_GRP * 768 + 384, Wb + WE_UKV, T_GRP, 2048, 256, 768}; E = pg8::EpiBf16{(bf16_t*)(SB + S_KV), 2048}; }
          pg8::StaticOrder S; S.init(g.M, g.N, G, blockIdx.x);
          pg8::gemm_phase(L, g, S, E);
        }
      } else if (op == 5) {
        rows_mla_a(P, j);
      } else if (op == 6) {
        rows_mla_b(P, j, grp);
      } else if (op == 7) {
        const int nqb = seqlen >> 8; const int nunits = nseq * 8 * nqb;
        const bf16_t* Qg = (const bf16_t*)(SB + S_Q); const bf16_t* KVg = (const bf16_t*)(SB + S_KV); const bf16_t* KPE = (const bf16_t*)(SB + S_KPE);
#ifndef REP_ATTN
#define REP_ATTN 1
#endif
#pragma unroll 1
        for (int rep = 0; rep < REP_ATTN; ++rep)
#pragma unroll 1
        for (int u = blockIdx.x; u < nunits; u += G) {
          int qb = u % nqb, pr = u / nqb;
          if (G == 256) {
            const int rnd = u >> 8, bb = u & 255, xx = bb & 7, vb = bb >> 3;
            if (nqb == 32) { pr = rnd * 8 + xx; qb = vb; } else { pr = rnd * 16 + xx * 2 + (vb >> 4); qb = vb & 15; }
          }
          const int hd = pr & 7, sq = pr >> 3;
          const size_t r0 = (size_t)sq * seqlen;
          att::attn_unit(Qg + (r0 + (size_t)qb * 256) * 1536 + hd * 192, KVg + r0 * 2048 + hd * 256, KPE + r0 * 512 + hd * 64,
                         XN + ((size_t)grp * T_GRP + r0 + (size_t)qb * 256) * DM + hd * 128, seqlen, (char*)lds_raw, (int)(uintptr_t)L);
        }
      } else if (op == 8) {
        const float* c256 = (const float*)(P.ws + WS_TAB) + 2 * 8192 * 32;
        pg8::Gemm g{XN + (size_t)grp * T_GRP * DM, Wb + WE_RIN, T_GRP, 6144, DM, DM}; pg8::StaticOrder S; S.init(T_GRP, 6144, G, blockIdx.x);
        pg8::EpiRet E{(bf16_t*)(SB + S_RQ), (bf16_t*)(SB + S_RK), (bf16_t*)(SB + S_RKT), (bf16_t*)(SB + S_RV), (bf16_t*)(SB + S_RG), c256, c256 + 8192 * 128, seqlen - 1};
#ifndef REP_RETPROJ
#define REP_RETPROJ 1
#endif
#pragma unroll 1
        for (int rep = 0; rep < REP_RETPROJ; ++rep) pg8::gemm_phase(L, g, S, E);
      } else if (op == 9) {
        bf16_t* Pg = (bf16_t*)(P.ws + WS_P);
#define LG2_OF(dec_) ({ const float xg_ = __builtin_amdgcn_exp2f((dec_) * 1.4426950408889634f); \
          const float ser_ = xg_ * (1.f + xg_ * (0.5f + xg_ * (0.33333334f + xg_ * (0.25f + xg_ * (0.2f + xg_ * (0.16666667f + xg_ * (0.14285715f + xg_ * 0.125f))))))); -ser_ * 1.4426950408889634f; })
#pragma unroll 1
        for (int u = blockIdx.x; u < (T_GRP / 64) * 4; u += G) {
          const int hd = u & 3, c = u >> 2;
          ret::p_unit(L, (const bf16_t*)(SB + S_RQ), (const bf16_t*)(SB + S_RK), (bf16_t*)(SB + S_RKT), Pg, c, hd, LG2_OF(P.r_df[j * 4 + hd]), LG2_OF(P.r_db[j * 4 + hd]));
        }
        GRID_BARRIER(P.ws);
        const int nitems = nseq * 4 * 2 * 16;
#ifndef REP_SCAN
#define REP_SCAN 1
#endif
#pragma unroll 1
        for (int rep = 0; rep < REP_SCAN; ++rep)
#pragma unroll 1
        for (int itx = blockIdx.x; itx < nitems; itx += G) {
          int sl = itx & 15, combo = itx >> 4;
          if (G == 256) {
            const int rnd = itx >> 8, bb = itx & 255, xx = bb & 7, vb = bb >> 3;
            sl = vb & 15; combo = rnd * 16 + xx * 2 + (vb >> 4);
          }
          const int dir = combo & 1, hd = (combo >> 1) & 3, sq = combo >> 3;
          const float lg2 = LG2_OF((dir ? P.r_db : P.r_df)[j * 4 + hd]);
          ret::scan_item(L, (const bf16_t*)(SB + S_RQ), (const bf16_t*)(SB + S_RKT), (const bf16_t*)(SB + S_RV), Pg,
                         (bf16_t*)(SB + (dir ? S_OB : S_OF)), seqlen, sq, hd, dir, sl, lg2);
        }
      } else if (op == 10) {
#ifndef REP_GN
#define REP_GN 1
#endif
        for (int rep = 0; rep < REP_GN; ++rep) rows_ret_gn(P, j);
      }
    }
#ifndef REP_BAR
#define REP_BAR 1
#endif
#ifdef TPROBE
    GRID_BARRIER(P.ws);
    { const int op = cls_op, p = cls_p, is_ret = cls_ret; (void)op; (void)p; (void)is_ret; if (TPROBE) tacc += __builtin_amdgcn_s_memrealtime() - tp0; }
#else
    if (ph + 1 < ph_hi) { for (int rb_ = 0; rb_ < REP_BAR; ++rb_) GRID_BARRIER(P.ws); }
#endif
  }
#ifdef TPROBE
  {
#ifndef TSCALE
#define TSCALE 50.f
#endif
    unsigned char* wsb = Pk.ws; unsigned* cnt = (unsigned*)(wsb + WS_BAR) + 3520;
    if (blockIdx.x == 0 && threadIdx.x == 0) __hip_atomic_store(cnt, (unsigned)(tacc / 100ull), __ATOMIC_RELAXED, __HIP_MEMORY_SCOPE_AGENT);
    GRID_BARRIER(wsb);
    const unsigned us = __hip_atomic_load(cnt, __ATOMIC_RELAXED, __HIP_MEMORY_SCOPE_AGENT);
    const float v = 10.f + (float)us / TSCALE;
    for (size_t i = (size_t)blockIdx.x * 512 + threadIdx.x; i < (size_t)T_ALL * DM; i += (size_t)G * 512) Pk.out[i] = v;
  }
#endif
#ifdef DBG_N
  {
    unsigned char* wsb = Pk.ws; float* Hh = Pk.out; const unsigned* XNw = (const unsigned*)(wsb + WS_XN);
    GRID_BARRIER(wsb);
    unsigned hsh = 0, nanc = 0; const size_t nth = (size_t)G * 512, gt = (size_t)blockIdx.x * 512 + threadIdx.x;
#if DBG_WHAT & 1
    for (size_t i = gt; i < (size_t)T_ALL * DM; i += nth) { const unsigned u = __float_as_uint(Hh[i]); hsh += u * 2654435761u + 1u; if ((u & 0x7f800000u) == 0x7f800000u) ++nanc; }
#endif
#if DBG_WHAT & 2
    for (size_t i = gt; i < (size_t)T_ALL * DM / 2; i += nth) { const unsigned u = XNw[i]; hsh += u * 2246822519u + 1u; if ((u & 0x7f800000u) == 0x7f800000u || (u & 0x7f80u) == 0x7f80u) ++nanc; }
#endif
#if DBG_WHAT & 4
    { const unsigned* Sw = (const unsigned*)(wsb + WS_S + DBG_OFF); for (size_t i = gt; i < (size_t)DBG_LEN / 4; i += nth) { const unsigned u = Sw[i]; hsh += u * 3266489917u + 1u; if ((u & 0x7f800000u) == 0x7f800000u || (u & 0x7f80u) == 0x7f80u) ++nanc; } }
#endif
    unsigned* cnt = (unsigned*)(wsb + WS_BAR) + 3520;
    atomicAdd(cnt, hsh); atomicAdd(cnt + 1, nanc);
    GRID_BARRIER(wsb);
    const unsigned th = __hip_atomic_load(cnt, __ATOMIC_RELAXED, __HIP_MEMORY_SCOPE_AGENT), tn = __hip_atomic_load(cnt + 1, __ATOMIC_RELAXED, __HIP_MEMORY_SCOPE_AGENT);
    const float v = (tn ? 30.f : 10.f) + (float)(th & 1023u) * 1e-3f;
    for (size_t i = gt; i < (size_t)T_ALL * DM; i += nth) Hh[i] = v;
  }
#endif
}

extern "C" void kernel_launch(void* const* d_in, const int* in_sizes, int n_in, void* d_out, int out_size, void* d_ws, size_t ws_size, hipStream_t stream) {
  static int grid_blocks = 0;
  if (grid_blocks == 0) {
    if (n_in != 20 || out_size != T_ALL * DM || ws_size < WS_END) { fprintf(stderr, "kernel_launch: unexpected shapes n_in %d out %d ws %zu (need %zu)\n", n_in, out_size, ws_size, (size_t)WS_END); }
    int dev = 0, cus = 0, per_cu = 0;
    (void)hipGetDevice(&dev);
    (void)hipDeviceGetAttribute(&cus, hipDeviceAttributeMultiprocessorCount, dev);
    if (hipFuncSetAttribute((const void*)mega, hipFuncAttributeMaxDynamicSharedMemorySize, LDS_BYTES) != hipSuccess) fprintf(stderr, "kernel_launch: hipFuncSetAttribute failed\n");
    if (hipOccupancyMaxActiveBlocksPerMultiprocessor(&per_cu, (const void*)mega, 512, LDS_BYTES) != hipSuccess || per_cu < 1) { fprintf(stderr, "kernel_launch: occupancy query gave %d\n", per_cu); per_cu = 1; }
    (void)hipGetLastError();
    grid_blocks = cus * per_cu;
  }
  Params p{};
  p.xp = (const float*)d_in[0]; p.xs = (const float*)d_in[1]; p.norm_g = (const float*)d_in[2]; p.ffn_g = (const float*)d_in[3]; p.ffn_u = (const float*)d_in[4]; p.ffn_d = (const float*)d_in[5];
  p.m_dq = (const float*)d_in[6]; p.m_qa = (const float*)d_in[7]; p.m_uq = (const float*)d_in[8]; p.m_dkv = (const float*)d_in[9]; p.m_kva = (const float*)d_in[10]; p.m_ukv = (const float*)d_in[11];
  p.m_qn = (const float*)d_in[12]; p.m_kn = (const float*)d_in[13]; p.m_wo = (const float*)d_in[14];
  p.r_in = (const float*)d_in[15]; p.r_df = (const float*)d_in[16]; p.r_db = (const float*)d_in[17]; p.r_gn = (const float*)d_in[18]; p.r_wo = (const float*)d_in[19];
  p.out = (float*)d_out; p.ws = (unsigned char*)d_ws; p.ph_lo = 0; p.ph_hi = N_PHASES;
#ifdef DBG_N
  p.ph_hi = DBG_N;
#endif
  (void)hipMemsetAsync((char*)d_ws + WS_BAR, 0, 16384, stream);
  void* args[] = {&p};
  hipError_t e = hipLaunchCooperativeKernel((const void*)mega, dim3(grid_blocks), dim3(512), args, LDS_BYTES, stream);
  if (e != hipSuccess) fprintf(stderr, "kernel_launch: cooperative launch failed: %s (grid %d)\n", hipGetErrorString(e), grid_blocks);
}
```
